# Optimizing an MI355X kernel written in HIP

```python
import jax, jax.numpy as jnp
from jax import lax
import numpy as np

D_MODEL = 1024
BATCH = 4
SEQ = 8192
DEPTH = 1

CHUNK = 64
EPS = 1e-6

HG_WIDTH = D_MODEL // 2
HG_DK = 128
HG_DV = 128
HG_HEADS = HG_WIDTH // HG_DK

RW_WIDTH = D_MODEL - HG_WIDTH
RW_HEAD = 64
RW_HEADS = RW_WIDTH // RW_HEAD
RW_DECAY_LORA = 64
RW_A_LORA = 64
RW_GATE_LORA = 128
RW_GN_EPS = 64e-5

HG_COLS = 4 * HG_WIDTH
RW_COLS = 3 * RW_WIDTH + RW_DECAY_LORA + RW_A_LORA + RW_GATE_LORA
IN_COLS = HG_COLS + RW_COLS

D_FF = ((8 * D_MODEL // 3 + 255) // 256) * 256

kernel_name = 'hymba_hgrn2_rwkv7_hybrid_block'


def rmsnorm(x, w):
    xf = x.astype(jnp.float32)
    y = xf * lax.rsqrt(jnp.mean(xf * xf, axis=-1, keepdims=True) + EPS)
    return (y * w.astype(jnp.float32)).astype(x.dtype)


def token_shift(p):
    return jnp.pad(p[:, :-1], ((0, 0), (1, 0), (0, 0)))


def hgrn2_mixer(q, f_logit, i, g, lb, norm_w):
    B, T, _ = q.shape
    N = T // CHUNK
    f32 = jnp.float32
    qf = jax.nn.silu(q.astype(f32))
    fs = lb + (1.0 - lb) * jax.nn.sigmoid(f_logit.astype(f32))
    logf = jnp.log(fs)
    kf = 1.0 - fs
    vf = i.astype(f32)

    def blocks(z, d):
        return z.reshape(B, N, CHUNK, HG_HEADS, d).transpose(0, 3, 1, 2, 4)

    qb, kb, lb_ = blocks(qf, HG_DK), blocks(kf, HG_DK), blocks(logf, HG_DK)
    vb = blocks(vf, HG_DV)
    b = jnp.cumsum(lb_, axis=3)
    b_ref = b[:, :, :, CHUNK // 2:CHUNK // 2 + 1]
    b_last = b[:, :, :, -1:]
    scores = jnp.einsum('bhnik,bhnjk->bhnij', qb * jnp.exp(b - b_ref), kb * jnp.exp(b_ref - b))
    mask = jnp.tril(jnp.ones((CHUNK, CHUNK), dtype=bool))
    scores = jnp.where(mask, scores, 0.0)
    o = jnp.einsum('bhnij,bhnjv->bhniv', scores, vb)
    U = jnp.einsum('bhnck,bhncv->bhnkv', kb * jnp.exp(b_last - b), vb)
    chunk_decay = jnp.exp(b_last[:, :, :, 0])

    def step(S, inp):
        dec, u = inp
        return dec[..., None] * S + u, S

    S0 = jnp.zeros((B, HG_HEADS, HG_DK, HG_DV), f32)
    _, S_prev = lax.scan(step, S0, (jnp.moveaxis(chunk_decay, 2, 0), jnp.moveaxis(U, 2, 0)))
    S_prev = jnp.moveaxis(S_prev, 0, 2)
    o = o + jnp.einsum('bhnck,bhnkv->bhncv', qb * jnp.exp(b), S_prev)
    o = o * lax.rsqrt(jnp.mean(o * o, axis=-1, keepdims=True) + EPS)
    o = o.transpose(0, 2, 3, 1, 4).reshape(B, T, HG_WIDTH)
    o = o * norm_w.astype(f32) * jax.nn.silu(g.astype(f32))
    return o.astype(q.dtype)


def rwkv7_mixer(p, mix, w0, w2, a0, a2, g2, k_k, k_a, r_k, ln_w, ln_b):
    B, T, _ = p.shape
    f32 = jnp.float32
    dtype = p.dtype
    pf = p.astype(f32)
    pf = pf + (token_shift(pf) - pf) * mix.astype(f32)
    r, k, v, dw, da, dg = jnp.split(pf, [RW_WIDTH, 2 * RW_WIDTH, 3 * RW_WIDTH,
                                         3 * RW_WIDTH + RW_DECAY_LORA,
                                         3 * RW_WIDTH + RW_DECAY_LORA + RW_A_LORA], axis=-1)
    w = -jax.nn.softplus(-(w0.astype(f32) + jnp.tanh(dw) @ w2.astype(f32))) - 0.5
    decay = jnp.exp(-jnp.exp(w))
    a = jax.nn.sigmoid(a0.astype(f32) + da @ a2.astype(f32))
    g = jax.nn.sigmoid(dg) @ g2.astype(f32)

    def heads(z):
        return z.reshape(B, T, RW_HEADS, RW_HEAD)

    kk = heads(k * k_k.astype(f32))
    kk = kk / jnp.maximum(jnp.sqrt(jnp.sum(kk * kk, axis=-1, keepdims=True)), 1e-12)
    k = k * (1.0 + (a - 1.0) * k_a.astype(f32))
    rh, wh, kh, vh, ah = heads(r), heads(decay), heads(k), heads(v), heads(a)

    def step(S, inp):
        r_t, w_t, k_t, v_t, kk_t, a_t = inp
        sa = jnp.einsum('bhvk,bhk->bhv', S, -kk_t)
        S = S * w_t[:, :, None, :] + sa[..., None] * (kk_t * a_t)[:, :, None, :] \
            + v_t[..., None] * k_t[:, :, None, :]
        return S, jnp.einsum('bhvk,bhk->bhv', S, r_t)

    S0 = jnp.zeros((B, RW_HEADS, RW_HEAD, RW_HEAD), f32)
    xs = tuple(jnp.moveaxis(z, 1, 0) for z in (rh, wh, kh, vh, kk, ah))
    _, y = lax.scan(step, S0, xs)
    y = jnp.moveaxis(y, 0, 1)
    mu = jnp.mean(y, axis=-1, keepdims=True)
    var = jnp.mean(jnp.square(y - mu), axis=-1, keepdims=True)
    y = ((y - mu) * lax.rsqrt(var + RW_GN_EPS)).reshape(B, T, RW_WIDTH)
    y = y * ln_w.astype(f32) + ln_b.astype(f32)
    bonus = jnp.sum(rh * kh * r_k.astype(f32), axis=-1, keepdims=True) * vh
    y = (y + bonus.reshape(B, T, RW_WIDTH)) * g
    return y.astype(dtype)


def setup_inputs(seed: int = 0) -> dict:
    key = jax.random.key(seed)
    ks = jax.random.split(key, 24)
    f32 = jnp.float32
    nrm = lambda k, shape, s: jax.random.normal(k, shape, f32) * s
    return {
        'x': jax.random.normal(ks[0], (BATCH, SEQ, D_MODEL), f32),
        'norm1_w': 1.0 + nrm(ks[1], (DEPTH, D_MODEL), 0.05),
        'w_in': nrm(ks[2], (DEPTH, D_MODEL, IN_COLS), D_MODEL ** -0.5),
        'hg_lower_bounds': nrm(ks[3], (DEPTH + 1, HG_WIDTH), 0.1),
        'hg_norm_w': 1.0 + nrm(ks[4], (DEPTH, HG_WIDTH), 0.05),
        'rw_mix': jax.random.uniform(ks[5], (DEPTH, RW_COLS), f32),
        'rw_w0': jax.random.uniform(ks[6], (DEPTH, RW_WIDTH), f32, -5.0, -0.5),
        'rw_w2': nrm(ks[7], (DEPTH, RW_DECAY_LORA, RW_WIDTH), 0.1 * RW_DECAY_LORA ** -0.5),
        'rw_a0': nrm(ks[8], (DEPTH, RW_WIDTH), 0.5),
        'rw_a2': nrm(ks[9], (DEPTH, RW_A_LORA, RW_WIDTH), 0.5 * RW_A_LORA ** -0.5),
        'rw_g2': nrm(ks[10], (DEPTH, RW_GATE_LORA, RW_WIDTH), RW_GATE_LORA ** -0.5),
        'rw_k_k': 0.85 + nrm(ks[11], (DEPTH, RW_WIDTH), 0.05),
        'rw_k_a': 1.0 + nrm(ks[12], (DEPTH, RW_WIDTH), 0.05),
        'rw_r_k': nrm(ks[13], (DEPTH, RW_HEADS, RW_HEAD), 0.1),
        'rw_ln_w': 1.0 + nrm(ks[14], (DEPTH, RW_WIDTH), 0.05),
        'rw_ln_b': nrm(ks[15], (DEPTH, RW_WIDTH), 0.02),
        'w_out': nrm(ks[16], (DEPTH, D_MODEL, D_MODEL), D_MODEL ** -0.5),
        'norm2_w': 1.0 + nrm(ks[17], (DEPTH, D_MODEL), 0.05),
        'ffn_w1': nrm(ks[18], (DEPTH, D_MODEL, D_FF), D_MODEL ** -0.5),
        'ffn_w3': nrm(ks[19], (DEPTH, D_MODEL, D_FF), D_MODEL ** -0.5),
        'ffn_w2': nrm(ks[20], (DEPTH, D_FF, D_MODEL), D_FF ** -0.5),
        'final_norm_w': 1.0 + nrm(ks[21], (D_MODEL,), 0.05),
    }


def reference(x, norm1_w, w_in, hg_lower_bounds, hg_norm_w, rw_mix, rw_w0, rw_w2, rw_a0,
              rw_a2, rw_g2, rw_k_k, rw_k_a, rw_r_k, rw_ln_w, rw_ln_b, w_out, norm2_w,
              ffn_w1, ffn_w3, ffn_w2, final_norm_w):
    lbs = jnp.cumsum(jax.nn.softmax(hg_lower_bounds.astype(jnp.float32), axis=0), axis=0)
    for l in range(DEPTH):
        h = rmsnorm(x, norm1_w[l])
        proj = h @ w_in[l]
        q, f_logit, i, g = jnp.split(proj[..., :HG_COLS], 4, axis=-1)
        o_hg = hgrn2_mixer(q, f_logit, i, g, lbs[l], hg_norm_w[l])
        o_rw = rwkv7_mixer(proj[..., HG_COLS:], rw_mix[l], rw_w0[l], rw_w2[l], rw_a0[l], rw_a2[l],
                           rw_g2[l], rw_k_k[l], rw_k_a[l], rw_r_k[l], rw_ln_w[l], rw_ln_b[l])
        x = x + jnp.concatenate([o_hg, o_rw], axis=-1) @ w_out[l]
        h = rmsnorm(x, norm2_w[l])
        x = x + (jax.nn.silu(h @ ffn_w1[l]) * (h @ ffn_w3[l])) @ ffn_w2[l]
    return rmsnorm(x, final_norm_w)
```

```cpp
#include <hip/hip_runtime.h>
#include <hip/hip_cooperative_groups.h>
#include <cstdio>
namespace cg = cooperative_groups;
namespace pg8 {
#define PG8_LAS __attribute__((address_space(3)))
typedef unsigned short bf16_t;
typedef short bf16x8 __attribute__((ext_vector_type(8)));
typedef float f32x4 __attribute__((ext_vector_type(4)));
typedef unsigned u32x4 __attribute__((ext_vector_type(4)));
constexpr int BM = 256, BK = 64, HALF = 128, HTB = HALF * BK * 2  , STAGE_BYTES = 8 * HTB, NXCD = 8, WGM = 8;

__host__ __device__ __forceinline__ int lds_byte(int r, int c) { const int st = (r >> 4) * 2 + (c >> 5), rr = r & 15, cc = c & 31, ob = rr * 64 + cc * 2; return st * 1024 + (ob ^ (((ob >> 9) & 1) << 5)); }
__host__ __device__ __forceinline__ void stage_rc(int b, int& R, int& C) { const int st = b / 1024, sb = b % 1024, swz = sb ^ (((sb >> 9) & 1) << 5); R = (st >> 1) * 16 + swz / 64; C = (st & 1) * 32 + (swz % 64) / 2; }
__host__ __device__ __forceinline__ int perm32(int rho) { const int n = rho >> 4, i = rho & 15; return 8 * (i >> 2) + 4 * n + (i & 3); }

struct Unit { int pm, pn; };
struct Gemm { const bf16_t* A; const bf16_t* Bt; int M, N, K; };

struct StaticOrder {
    int nM, nN, nwg, G, c;
    __host__ __device__ void init(int M, int N, int G_, int c_) { nM = M / BM; nN = N / BM; nwg = nM * nN; G = G_; c = c_; }
    __host__ __device__ bool next(int i, Unit& u) const {
        const long L = (long)i * G + c; if (L >= nwg) return false;
        int wgid = (int)L; { const int q = nwg / NXCD, r = nwg % NXCD, xcd = wgid % NXCD, off = wgid / NXCD; wgid = (xcd < r ? xcd * (q + 1) : r * (q + 1) + (xcd - r) * q) + off; }
        const int nig = WGM * nN, gid = wgid / nig, fm = gid * WGM, gsz = (nM - fm) < WGM ? (nM - fm) : WGM;
        u.pm = fm + ((wgid % nig) % gsz); u.pn = (wgid % nig) / gsz; return true;
    }
    __device__ __forceinline__ void a_ready(const Unit&) const {}
    __device__ __forceinline__ void done(const Unit&) const {}
};
__device__ __forceinline__ unsigned cvt_pk_bf16(float lo, float hi) { unsigned r; asm volatile("v_cvt_pk_bf16_f32 %0, %1, %2" : "=v"(r) : "v"(lo), "v"(hi)); return r; }
__device__ __forceinline__ float sigm(float v) { return __builtin_amdgcn_rcpf(1.0f + __expf(-v)); }
struct EpiProj {
    static constexpr bool PERM = true, AFTER_DRAIN = false;
    bf16_t* HG; bf16_t* RW; const float* LB;
    __device__ __forceinline__ void operator()(const f32x4 (&acc)[2][2][4][2], const Unit& u, int wr, int wc, int fr, int fq) const {
        const int row0 = u.pm * BM + wr * 64 + fr, cb = u.pn * BM + wc * 32 + 8 * fq;
        const int mode = u.pn < 2 ? 0 : (u.pn < 4 ? 1 : 2);
#pragma unroll
        for (int bj = 0; bj < 2; ++bj) {
            const int col = cb + bj * HALF;
            f32x4 l0 = (f32x4){0.f, 0.f, 0.f, 0.f}, l1 = l0;
            if (mode == 1) { l0 = *(const f32x4*)(LB + col - 512); l1 = *(const f32x4*)(LB + col - 512 + 4); }
#pragma unroll
            for (int ai = 0; ai < 2; ++ai)
#pragma unroll
                for (int m = 0; m < 4; ++m) {
                    const int row = row0 + ai * HALF + m * 16;
                    f32x4 v0 = acc[ai][bj][m][0], v1 = acc[ai][bj][m][1];
                    if (mode == 0) {
#pragma unroll
                        for (int j = 0; j < 4; ++j) { v0[j] = v0[j] * sigm(v0[j]); v1[j] = v1[j] * sigm(v1[j]); }
                    } else if (mode == 1) {
#pragma unroll
                        for (int j = 0; j < 4; ++j) { v0[j] = l0[j] + (1.0f - l0[j]) * sigm(v0[j]); v1[j] = l1[j] + (1.0f - l1[j]) * sigm(v1[j]); }
                    }
                    u32x4 w; w.x = cvt_pk_bf16(v0[0], v0[1]); w.y = cvt_pk_bf16(v0[2], v0[3]); w.z = cvt_pk_bf16(v1[0], v1[1]); w.w = cvt_pk_bf16(v1[2], v1[3]);
                    bf16_t* dst = (u.pn < 8) ? HG + (size_t)row * 2048 + col : RW + (size_t)row * 1792 + (col - 2048);
                    *(u32x4*)dst = w;
                }
        }
    }
};
template <bool WB> struct EpiRes {
    static constexpr bool PERM = true, AFTER_DRAIN = false;
    const float* X; float* X1; bf16_t* X1B; const float* NW; float* SSQ;
    __device__ __forceinline__ void operator()(const f32x4 (&acc)[2][2][4][2], const Unit& u, int wr, int wc, int fr, int fq) const {
        const int row0 = u.pm * BM + wr * 64 + fr, cb = u.pn * BM + wc * 32 + 8 * fq;
#pragma unroll
        for (int ai = 0; ai < 2; ++ai)
#pragma unroll
            for (int m = 0; m < 4; ++m) {
                const int row = row0 + ai * HALF + m * 16; float ss = 0.f;
#pragma unroll
                for (int bj = 0; bj < 2; ++bj) {
                    const size_t off = (size_t)row * 1024 + cb + bj * HALF;
                    f32x4 v0 = acc[ai][bj][m][0] + *(const f32x4*)(X + off), v1 = acc[ai][bj][m][1] + *(const f32x4*)(X + off + 4);
                    *(f32x4*)(X1 + off) = v0; *(f32x4*)(X1 + off + 4) = v1;
                    ss += (v0[0] * v0[0] + v0[1] * v0[1]) + (v0[2] * v0[2] + v0[3] * v0[3]) + (v1[0] * v1[0] + v1[1] * v1[1]) + (v1[2] * v1[2] + v1[3] * v1[3]);
                    if (WB) { const f32x4 n0 = *(const f32x4*)(NW + cb + bj * HALF), n1 = *(const f32x4*)(NW + cb + bj * HALF + 4);
                        u32x4 w; w.x = cvt_pk_bf16(v0[0] * n0[0], v0[1] * n0[1]); w.y = cvt_pk_bf16(v0[2] * n0[2], v0[3] * n0[3]); w.z = cvt_pk_bf16(v1[0] * n1[0], v1[1] * n1[1]); w.w = cvt_pk_bf16(v1[2] * n1[2], v1[3] * n1[3]);
                        *(u32x4*)(X1B + off) = w; }
                }
                ss += __shfl_xor(ss, 16); ss += __shfl_xor(ss, 32);
                if (fq == 0) unsafeAtomicAdd(SSQ + row, ss);
            }
    }
};
struct EpiGlu {
    static constexpr bool PERM = true, AFTER_DRAIN = false;
    bf16_t* U; const float* SSQ;
    __device__ __forceinline__ void operator()(const f32x4 (&acc)[2][2][4][2], const Unit& u, int wr, int wc, int fr, int fq) const {
        const int row0 = u.pm * BM + wr * 64 + fr, cb = (u.pn * BM + wc * 32 + 8 * fq) >> 1;
#pragma unroll
        for (int ai = 0; ai < 2; ++ai)
#pragma unroll
            for (int m = 0; m < 4; ++m) {
                const int row = row0 + ai * HALF + m * 16;
                const float rstd = __builtin_amdgcn_rsqf(SSQ[row] * (1.0f / 1024.0f) + 1e-6f);
#pragma unroll
                for (int bj = 0; bj < 2; ++bj) {
                    const f32x4 g = acc[ai][bj][m][0] * rstd, up = acc[ai][bj][m][1] * rstd; float h[4];
#pragma unroll
                    for (int j = 0; j < 4; ++j) h[j] = g[j] * sigm(g[j]) * up[j];
                    typedef unsigned u32x2 __attribute__((ext_vector_type(2)));
                    u32x2 w; w.x = cvt_pk_bf16(h[0], h[1]); w.y = cvt_pk_bf16(h[2], h[3]);
                    *(u32x2*)(U + (size_t)row * 2816 + cb + bj * (HALF / 2)) = w;
                }
            }
    }
};

template <class Epi, class Sched, bool STAMP = false>
__device__ __forceinline__ void gemm_phase(PG8_LAS unsigned char* lds, const Gemm g, const Sched& S, const Epi& E, unsigned long long* stamps) {
    const int tid = threadIdx.x, wid = __builtin_amdgcn_readfirstlane(tid >> 6), lane = tid & 63, wr = wid >> 2, wc = wid & 3, fr = lane & 15, fq = lane >> 4;
    const int K = g.K, nt = K / BK;
    int ts_lo = 0, ts_hi = 0, nts = 0; const unsigned long long rt_entry = STAMP ? (unsigned long long)wall_clock64() : 0ull;
#define PG8_STAMP() do { if (STAMP && wid == 0 && nts < 64) { const unsigned long long _c = (unsigned long long)clock64(); \
        ts_lo = (lane == nts) ? (int)(unsigned)_c : ts_lo; ts_hi = (lane == nts) ? (int)(unsigned)(_c >> 32) : ts_hi; ++nts; } } while (0)
    PG8_STAMP();
    unsigned voffA[2], voffB[2];
#pragma unroll
    for (int i = 0; i < 2; ++i) { int R, C; stage_rc(tid * 16 + i * 8192, R, C); const int Rb = Epi::PERM ? ((R & ~31) + perm32(R & 31)) : R;
        voffA[i] = (unsigned)(R * K + C) * 2u; voffB[i] = (unsigned)(Rb * K + C) * 2u; }
    const size_t kstep = (size_t)(BK * 2);
    const size_t hstep = (size_t)HALF * K * 2;
    const size_t tstep = 2 * hstep;
    const unsigned ldsw = (unsigned)wid * 1024u;
    const int aoff = lds_byte(wr * 64 + fr, fq * 8), boff = lds_byte(wc * 32 + fr, fq * 8);
#define PG8_SA(b, h) (((b) * 2 + (h)) * HTB)
#define PG8_SB(b, h) ((4 + (b) * 2 + (h)) * HTB)
#define PG8_STAGE(bufoff, gbase, voff) do { _Pragma("unroll") for (int _i = 0; _i < 2; ++_i) \
        __builtin_amdgcn_global_load_lds((const unsigned*)((const char*)(gbase) + (voff)[_i]), (PG8_LAS unsigned*)(lds + (bufoff) + ldsw + _i * 8192), 16, 0, 0); } while (0)
#define PG8_LDA(dst, b, h) do { _Pragma("unroll") for (int m = 0; m < 4; ++m) _Pragma("unroll") for (int k = 0; k < 2; ++k) dst[m][k] = *(const PG8_LAS bf16x8*)(lds + PG8_SA(b, h) + aoff + m * 2048 + k * 1024); } while (0)
#define PG8_LDB(dst, b, h) do { _Pragma("unroll") for (int n = 0; n < 2; ++n) _Pragma("unroll") for (int k = 0; k < 2; ++k) dst[n][k] = *(const PG8_LAS bf16x8*)(lds + PG8_SB(b, h) + boff + n * 2048 + k * 1024); } while (0)
#define PG8_MMA(ai, bj, At, Bt) do { __builtin_amdgcn_s_setprio(1); _Pragma("unroll") for (int m = 0; m < 4; ++m) _Pragma("unroll") for (int n = 0; n < 2; ++n) _Pragma("unroll") for (int k = 0; k < 2; ++k) \
        acc[ai][bj][m][n] = __builtin_amdgcn_mfma_f32_16x16x32_bf16(Bt[n][k], At[m][k], acc[ai][bj][m][n], 0, 0, 0); __builtin_amdgcn_s_setprio(0); } while (0)
#define PG8_WAIT_V(n) asm volatile("s_waitcnt vmcnt(" #n ")" ::: "memory")
#define PG8_WAIT_L(n) asm volatile("s_waitcnt lgkmcnt(" #n ")" ::: "memory")
#define PG8_BAR __builtin_amdgcn_s_barrier()
#define PG8_SCHED __builtin_amdgcn_sched_barrier(0)
    Unit cur, nxt; int ui = 0;
    if (!S.next(0, cur)) return;
    f32x4 acc[2][2][4][2];
#pragma unroll
    for (int a = 0; a < 2; ++a)
#pragma unroll
        for (int b = 0; b < 2; ++b)
#pragma unroll
            for (int m = 0; m < 4; ++m)
#pragma unroll
                for (int n = 0; n < 2; ++n) acc[a][b][m][n] = (f32x4){0.f, 0.f, 0.f, 0.f};
    bf16x8 At[4][2], B0[2][2], B1[2][2];
    const char* cA = (const char*)g.A + (size_t)cur.pm * tstep; const char* cB = (const char*)g.Bt + (size_t)cur.pn * tstep;
    S.a_ready(cur);
    PG8_STAGE(PG8_SB(0, 0), cB, voffB); PG8_STAGE(PG8_SA(0, 0), cA, voffA); PG8_STAGE(PG8_SB(0, 1), cB + hstep, voffB); PG8_STAGE(PG8_SA(0, 1), cA + hstep, voffA);
    if (wr == 1) PG8_BAR;
    PG8_WAIT_V(4); PG8_BAR;
    PG8_STAGE(PG8_SB(1, 0), cB + kstep, voffB); PG8_STAGE(PG8_SA(1, 0), cA + kstep, voffA); PG8_STAGE(PG8_SB(1, 1), cB + hstep + kstep, voffB);
    PG8_WAIT_V(6); PG8_BAR;
    PG8_STAMP();
    for (;;) {
        const bool has_next = S.next(ui + 1, nxt);
        const char* nA = has_next ? (const char*)g.A + (size_t)nxt.pm * tstep : cA; const char* nB = has_next ? (const char*)g.Bt + (size_t)nxt.pn * tstep : cB;
        for (int t = 0; t < nt; t += 2) {
            const bool last = (t == nt - 2);
            const char* a1 = cA + (size_t)(t + 1) * kstep;
            const char* a2 = last ? nA : cA + (size_t)(t + 2) * kstep; const char* b2 = last ? nB : cB + (size_t)(t + 2) * kstep;
            const char* a3 = a2 + kstep; const char* b3 = b2 + kstep;
            if (last && has_next) S.a_ready(nxt);
            PG8_LDB(B0, 0, 0); PG8_SCHED; PG8_LDA(At, 0, 0); PG8_STAGE(PG8_SA(1, 1), a1 + hstep, voffA);
            PG8_WAIT_L(8); PG8_BAR; PG8_WAIT_L(0); PG8_MMA(0, 0, At, B0); PG8_BAR; PG8_SCHED;
            PG8_LDB(B1, 0, 1); PG8_STAGE(PG8_SB(0, 0), b2, voffB);
            PG8_BAR; PG8_WAIT_L(0); PG8_MMA(0, 1, At, B1); PG8_BAR;
            PG8_LDA(At, 0, 1); PG8_STAGE(PG8_SA(0, 0), a2, voffA);
            PG8_BAR; PG8_WAIT_L(0); PG8_MMA(1, 0, At, B0); PG8_BAR; PG8_SCHED;
            PG8_STAGE(PG8_SB(0, 1), b2 + hstep, voffB);
            PG8_WAIT_V(6); PG8_BAR; PG8_MMA(1, 1, At, B1); PG8_BAR;
            PG8_LDB(B0, 1, 0); PG8_SCHED; PG8_LDA(At, 1, 0); PG8_STAGE(PG8_SA(0, 1), a2 + hstep, voffA);
            PG8_WAIT_L(8); PG8_BAR; PG8_WAIT_L(0); PG8_MMA(0, 0, At, B0); PG8_BAR; PG8_SCHED;
            PG8_LDB(B1, 1, 1); PG8_STAGE(PG8_SB(1, 0), b3, voffB);
            PG8_BAR; PG8_WAIT_L(0); PG8_MMA(0, 1, At, B1); PG8_BAR;
            PG8_LDA(At, 1, 1); PG8_STAGE(PG8_SA(1, 0), a3, voffA);
            PG8_BAR; PG8_WAIT_L(0); PG8_MMA(1, 0, At, B0); PG8_BAR; PG8_SCHED;
            PG8_STAGE(PG8_SB(1, 1), b3 + hstep, voffB);
            PG8_WAIT_V(6); PG8_BAR; PG8_MMA(1, 1, At, B1); PG8_BAR;
        }
        PG8_STAMP();
        if constexpr (!Epi::AFTER_DRAIN) { E(acc, cur, wr, wc, fr, fq); S.done(cur); }
        PG8_STAMP();
        if (!has_next) break;
#pragma unroll
        for (int a = 0; a < 2; ++a)
#pragma unroll
            for (int b = 0; b < 2; ++b)
#pragma unroll
                for (int m = 0; m < 4; ++m)
#pragma unroll
                    for (int n = 0; n < 2; ++n) acc[a][b][m][n] = (f32x4){0.f, 0.f, 0.f, 0.f};
        cur = nxt; cA = nA; cB = nB; ++ui;
    }
    PG8_WAIT_V(0);
    if (wr == 0) PG8_BAR;
    PG8_BAR;
    if constexpr (Epi::AFTER_DRAIN) { E.fused(acc, cur, wr, wc, fr, fq, lds, wid, lane); S.done(cur); }
    PG8_STAMP();
    if (STAMP && wid == 0) { stamps[lane] = lane < nts ? (((unsigned long long)(unsigned)ts_hi << 32) | (unsigned)ts_lo) : 0ull;
        if (lane == 62) stamps[62] = rt_entry; if (lane == 63) stamps[63] = (unsigned long long)wall_clock64(); }
#undef PG8_STAMP
#undef PG8_SA
#undef PG8_SB
#undef PG8_STAGE
#undef PG8_LDA
#undef PG8_LDB
#undef PG8_MMA
#undef PG8_WAIT_V
#undef PG8_WAIT_L
#undef PG8_BAR
#undef PG8_SCHED
}
}
#define LAS __attribute__((address_space(3)))
typedef unsigned short bf16;
typedef float f32x4 __attribute__((ext_vector_type(4)));
typedef unsigned u32x4 __attribute__((ext_vector_type(4)));
typedef unsigned u32x2 __attribute__((ext_vector_type(2)));
typedef short bf16x8 __attribute__((ext_vector_type(8)));
constexpr int M = 32768, T = 8192, D = 1024, FF = 2816;
constexpr size_t MiB = 1u << 20;
constexpr size_t WS_LB = 0, WS_SSQ1 = 65536, WS_SSQ2 = 65536 + 131072;
constexpr size_t WS_WTIN = 2 * MiB, WS_WTOUT = 10 * MiB, WS_WT13 = 12 * MiB, WS_WT2 = 23 * MiB, WS_LT = 29 * MiB;
constexpr size_t WS_HG = 32 * MiB, WS_RW = 160 * MiB, WS_Y = 160 * MiB, WS_W = 272 * MiB, WS_KK = 336 * MiB, WS_BB = 368 * MiB, WS_KM = 400 * MiB, WS_R = 432 * MiB, WS_V = 464 * MiB;
constexpr size_t WS_MIX = 336 * MiB, WS_X1B = 272 * MiB, WS_U = 32 * MiB, WS_END = 496 * MiB;
constexpr size_t DO_XN = 0, DO_G = 0, DO_OH = 32 * MiB;
constexpr int LDS_BYTES = 147456;
constexpr int NPHASE = 9;
#ifndef N_LAUNCHES
#define N_LAUNCHES 1
#endif

__device__ __forceinline__ unsigned f2bf(float f) { unsigned u = __float_as_uint(f); return (u + 0x7fffu + ((u >> 16) & 1u)) >> 16; }
__device__ __forceinline__ unsigned pk2(float lo, float hi) { return f2bf(lo) | (f2bf(hi) << 16); }
__device__ __forceinline__ float bflo(unsigned u) { return __uint_as_float(u << 16); }
__device__ __forceinline__ float bfhi(unsigned u) { return __uint_as_float(u & 0xffff0000u); }
__device__ __forceinline__ float bf1(bf16 b) { return __uint_as_float(((unsigned)b) << 16); }
__device__ __forceinline__ float sigmf(float v) { return __builtin_amdgcn_rcpf(1.0f + __expf(-v)); }
__device__ __forceinline__ float wave_sum(float v) {
#pragma unroll
    for (int o = 1; o < 64; o <<= 1) v += __shfl_xor(v, o);
    return v;
}
template <int CTRL> __device__ __forceinline__ float dpp_add(float v) { return v + __int_as_float(__builtin_amdgcn_update_dpp(__float_as_int(v), __float_as_int(v), CTRL, 0xf, 0xf, false)); }
__device__ __forceinline__ float rowsum16(float v) { v = dpp_add<0xB1>(v); v = dpp_add<0x4E>(v); v = dpp_add<0x141>(v); v = dpp_add<0x140>(v); return v; }

struct Args { const float* in[22]; float* out; unsigned char* ws; int ph_lo, ph_hi; };

__device__ __forceinline__ void p0_transpose_item(const float* W, int K, int N, bf16* WT, int ld, int koff, int mode, LAS float* scr, int item, int lane) {
    const int nblk = N / 32, kb = item / nblk, nb = item % nblk, k0 = 64 * kb, n0 = 32 * nb;
#pragma unroll 8
    for (int i = 0; i < 32; ++i) { const int kk = 2 * i + (lane >> 5); scr[kk * 33 + (lane & 31)] = W[(size_t)(k0 + kk) * N + n0 + (lane & 31)]; }
    asm volatile("s_waitcnt lgkmcnt(0)" ::: "memory");
    const int c = lane & 7;
#pragma unroll
    for (int j = 0; j < 4; ++j) { const int n = (lane >> 3) + 8 * j; const LAS float* s = scr + (8 * c) * 33 + n;
        u32x4 o; o.x = pk2(s[0 * 33], s[1 * 33]); o.y = pk2(s[2 * 33], s[3 * 33]); o.z = pk2(s[4 * 33], s[5 * 33]); o.w = pk2(s[6 * 33], s[7 * 33]);
        const int ng = n0 + n, row = mode == 0 ? ng : ((ng >> 2) * 8 + (ng & 3) + (mode == 2 ? 4 : 0));
        *(u32x4*)(WT + (size_t)row * ld + koff + k0 + 8 * c) = o; }
    asm volatile("s_waitcnt lgkmcnt(0)" ::: "memory");
}
__device__ __forceinline__ void phase0(const Args& a, LAS unsigned char* lds) {
    const int tid = threadIdx.x, lane = tid & 63, wave = tid >> 6, gw = blockIdx.x * 8 + wave, NGW = gridDim.x * 8;
    unsigned char* ws = a.ws;
    LAS float* scr = (LAS float*)(lds + wave * 16384);
    constexpr int I_IN = 16 * 120, I_OUT = 16 * 32, I_1 = 16 * 88, I_2 = 44 * 32, I_L = 16, I_G = 32;
    constexpr int NITEMS = I_IN + I_OUT + 2 * I_1 + I_2 + 2 * I_L + I_G;
    for (int it = gw; it < NITEMS; it += NGW) {
        int r = it;
        if (r < I_IN) { p0_transpose_item(a.in[2], 1024, 3840, (bf16*)(ws + WS_WTIN), 1024, 0, 0, scr, r, lane); continue; } r -= I_IN;
        if (r < I_OUT) { p0_transpose_item(a.in[16], 1024, 1024, (bf16*)(ws + WS_WTOUT), 1024, 0, 0, scr, r, lane); continue; } r -= I_OUT;
        if (r < I_1) { p0_transpose_item(a.in[18], 1024, 2816, (bf16*)(ws + WS_WT13), 1024, 0, 1, scr, r, lane); continue; } r -= I_1;
        if (r < I_1) { p0_transpose_item(a.in[19], 1024, 2816, (bf16*)(ws + WS_WT13), 1024, 0, 2, scr, r, lane); continue; } r -= I_1;
        if (r < I_2) { p0_transpose_item(a.in[20], 2816, 1024, (bf16*)(ws + WS_WT2), 2816, 0, 0, scr, r, lane); continue; } r -= I_2;
        if (r < I_L) { p0_transpose_item(a.in[7], 64, 512, (bf16*)(ws + WS_LT), 256, 0, 0, scr, r, lane); continue; } r -= I_L;
        if (r < I_L) { p0_transpose_item(a.in[9], 64, 512, (bf16*)(ws + WS_LT), 256, 64, 0, scr, r, lane); continue; } r -= I_L;
        p0_transpose_item(a.in[10], 128, 512, (bf16*)(ws + WS_LT), 256, 128, 0, scr, r, lane);
    }
    const float* x = a.in[0]; const float* nw = a.in[1]; bf16* XN = (bf16*)((unsigned char*)a.out + DO_XN);
    f32x4 wv[4];
#pragma unroll
    for (int j = 0; j < 4; ++j) wv[j] = *((const f32x4*)nw + 64 * j + lane);
    for (int m = gw; m < M; m += NGW) {
        const f32x4* xr = (const f32x4*)(x + (size_t)m * D) + lane;
        f32x4 v[4]; float s = 0.f;
#pragma unroll
        for (int j = 0; j < 4; ++j) { v[j] = xr[64 * j]; s += (v[j].x * v[j].x + v[j].y * v[j].y) + (v[j].z * v[j].z + v[j].w * v[j].w); }
        const float rstd = __builtin_amdgcn_rsqf(wave_sum(s) * (1.f / D) + 1e-6f);
        u32x2* o8 = (u32x2*)(XN + (size_t)m * D) + lane;
#pragma unroll
        for (int j = 0; j < 4; ++j) { u32x2 o; o.x = pk2(v[j].x * rstd * wv[j].x, v[j].y * rstd * wv[j].y); o.y = pk2(v[j].z * rstd * wv[j].z, v[j].w * rstd * wv[j].w); o8[64 * j] = o; }
    }
    const int gt = blockIdx.x * 512 + tid, NGT = gridDim.x * 512;
    if (gt < 512) { const float* hb = a.in[3]; ((float*)(ws + WS_LB))[gt] = 1.0f / (1.0f + __expf(hb[512 + gt] - hb[gt])); }
    for (int i = gt; i < 2 * M; i += NGT) ((float*)(ws + WS_SSQ1))[i] = 0.f;
}

constexpr int ALD = 264;
__device__ __forceinline__ void phase2(const Args& a, LAS unsigned char* lds) {
    const int tid = threadIdx.x, lane = tid & 63, wave = tid >> 6, tok = lane & 15, q = lane >> 4;
    unsigned char* ws = a.ws;
    const bf16* RW = (const bf16*)(ws + WS_RW); const bf16* LT = (const bf16*)(ws + WS_LT);
    const float* mix = a.in[5]; const float* w0 = a.in[6]; const float* a0 = a.in[8]; const float* k_k = a.in[11]; const float* k_a = a.in[12];
    float* Wd = (float*)(ws + WS_W); bf16* KK = (bf16*)(ws + WS_KK); bf16* BB = (bf16*)(ws + WS_BB); bf16* KM = (bf16*)(ws + WS_KM); bf16* R = (bf16*)(ws + WS_R); bf16* V = (bf16*)(ws + WS_V);
    bf16* G = (bf16*)((unsigned char*)a.out + DO_G);
    LAS bf16* A = (LAS bf16*)lds;
    for (int item = blockIdx.x; item < M / 64; item += gridDim.x) {
        const int row0 = item * 64;
        __syncthreads();
#pragma unroll
        for (int i = 0; i < 4; ++i) {
            const int vi = tid + 512 * i, t = vi >> 5, cg8 = vi & 31, row = row0 + t, col = 1536 + 8 * cg8;
            const u32x4 p = *(const u32x4*)(RW + (size_t)row * 1792 + col);
            u32x4 pp = (u32x4){0u, 0u, 0u, 0u};
            if ((row & (T - 1)) != 0) pp = *(const u32x4*)(RW + (size_t)(row - 1) * 1792 + col);
            const f32x4 m0 = *(const f32x4*)(mix + col), m1 = *(const f32x4*)(mix + col + 4);
            float f[8];
            f[0] = bflo(p.x) + (bflo(pp.x) - bflo(p.x)) * m0.x; f[1] = bfhi(p.x) + (bfhi(pp.x) - bfhi(p.x)) * m0.y;
            f[2] = bflo(p.y) + (bflo(pp.y) - bflo(p.y)) * m0.z; f[3] = bfhi(p.y) + (bfhi(pp.y) - bfhi(p.y)) * m0.w;
            f[4] = bflo(p.z) + (bflo(pp.z) - bflo(p.z)) * m1.x; f[5] = bfhi(p.z) + (bfhi(pp.z) - bfhi(p.z)) * m1.y;
            f[6] = bflo(p.w) + (bflo(pp.w) - bflo(p.w)) * m1.z; f[7] = bfhi(p.w) + (bfhi(pp.w) - bfhi(p.w)) * m1.w;
            if (cg8 < 8) {
#pragma unroll
                for (int j = 0; j < 8; ++j) f[j] = 1.0f - 2.0f * __builtin_amdgcn_rcpf(1.0f + __expf(2.0f * f[j]));
            } else if (cg8 >= 16) {
#pragma unroll
                for (int j = 0; j < 8; ++j) f[j] = sigmf(f[j]);
            }
            u32x4 o; o.x = pk2(f[0], f[1]); o.y = pk2(f[2], f[3]); o.z = pk2(f[4], f[5]); o.w = pk2(f[6], f[7]);
            *(LAS u32x4*)(A + t * ALD + 8 * cg8) = o;
        }
        __syncthreads();
        for (int mt = 0; mt < 4; ++mt) {
            f32x4 aw[4], aa[4], ag[4];
#pragma unroll
            for (int nt = 0; nt < 4; ++nt) { aw[nt] = (f32x4){0.f, 0.f, 0.f, 0.f}; aa[nt] = aw[nt]; ag[nt] = aw[nt]; }
            bf16x8 xf[8];
#pragma unroll
            for (int ks = 0; ks < 8; ++ks) xf[ks] = *(const LAS bf16x8*)(A + (16 * mt + tok) * ALD + 32 * ks + 8 * q);
#pragma unroll
            for (int nt = 0; nt < 4; ++nt) {
                const bf16* lrow = LT + (size_t)(64 * wave + 16 * nt + tok) * 256 + 8 * q;
#pragma unroll
                for (int ks = 0; ks < 8; ++ks) {
                    const bf16x8 wf = *(const bf16x8*)(lrow + 32 * ks);
                    if (ks < 2) aw[nt] = __builtin_amdgcn_mfma_f32_16x16x32_bf16(wf, xf[ks], aw[nt], 0, 0, 0);
                    else if (ks < 4) aa[nt] = __builtin_amdgcn_mfma_f32_16x16x32_bf16(wf, xf[ks], aa[nt], 0, 0, 0);
                    else ag[nt] = __builtin_amdgcn_mfma_f32_16x16x32_bf16(wf, xf[ks], ag[nt], 0, 0, 0);
                }
            }
            const int row = row0 + 16 * mt + tok; const bool hasprev = (row & (T - 1)) != 0;
            const bf16* pr = RW + (size_t)row * 1792; const bf16* ppr = pr - 1792;
            float kkv[4][4], av[4][4]; float ss = 0.f;
#pragma unroll
            for (int nt = 0; nt < 4; ++nt) {
                const int c = 64 * wave + 16 * nt + 4 * q;
                float rr[4], kk[4], vv[4];
#pragma unroll
                for (int part = 0; part < 3; ++part) {
                    const u32x2 p = *(const u32x2*)(pr + 512 * part + c); u32x2 pp = (u32x2){0u, 0u};
                    if (hasprev) pp = *(const u32x2*)(ppr + 512 * part + c);
                    const f32x4 mx = *(const f32x4*)(mix + 512 * part + c);
                    float* dst = part == 0 ? rr : (part == 1 ? kk : vv);
                    dst[0] = bflo(p.x) + (bflo(pp.x) - bflo(p.x)) * mx.x; dst[1] = bfhi(p.x) + (bfhi(pp.x) - bfhi(p.x)) * mx.y;
                    dst[2] = bflo(p.y) + (bflo(pp.y) - bflo(p.y)) * mx.z; dst[3] = bfhi(p.y) + (bfhi(pp.y) - bfhi(p.y)) * mx.w;
                }
                const f32x4 w0v = *(const f32x4*)(w0 + c), a0v = *(const f32x4*)(a0 + c), kkw = *(const f32x4*)(k_k + c), kaw = *(const f32x4*)(k_a + c);
                f32x4 dec; float km[4];
#pragma unroll
                for (int j = 0; j < 4; ++j) {
                    const float z = -(w0v[j] + aw[nt][j]);
                    const float sp = fmaxf(z, 0.f) + __logf(1.0f + __expf(-fabsf(z)));
                    dec[j] = __expf(-__expf(-sp - 0.5f));
                    const float al = sigmf(a0v[j] + aa[nt][j]);
                    av[nt][j] = al;
                    kkv[nt][j] = kk[j] * kkw[j]; ss += kkv[nt][j] * kkv[nt][j];
                    km[j] = kk[j] * (1.0f + (al - 1.0f) * kaw[j]);
                }
                const size_t o = (size_t)row * 512 + c;
                *(f32x4*)(Wd + o) = dec;
                u32x2 t2; t2.x = pk2(rr[0], rr[1]); t2.y = pk2(rr[2], rr[3]); *(u32x2*)(R + o) = t2;
                t2.x = pk2(km[0], km[1]); t2.y = pk2(km[2], km[3]); *(u32x2*)(KM + o) = t2;
                t2.x = pk2(vv[0], vv[1]); t2.y = pk2(vv[2], vv[3]); *(u32x2*)(V + o) = t2;
                t2.x = pk2(ag[nt][0], ag[nt][1]); t2.y = pk2(ag[nt][2], ag[nt][3]); *(u32x2*)(G + o) = t2;
            }
            ss += __shfl_xor(ss, 16); ss += __shfl_xor(ss, 32);
            const float inv = 1.0f / fmaxf(sqrtf(ss), 1e-12f);
#pragma unroll
            for (int nt = 0; nt < 4; ++nt) {
                const size_t o = (size_t)row * 512 + 64 * wave + 16 * nt + 4 * q;
                float kn[4];
#pragma unroll
                for (int j = 0; j < 4; ++j) kn[j] = kkv[nt][j] * inv;
                u32x2 t2; t2.x = pk2(kn[0], kn[1]); t2.y = pk2(kn[2], kn[3]); *(u32x2*)(KK + o) = t2;
                t2.x = pk2(kn[0] * av[nt][0], kn[1] * av[nt][1]); t2.y = pk2(kn[2] * av[nt][2], kn[3] * av[nt][3]); *(u32x2*)(BB + o) = t2;
            }
        }
    }
}
__device__ __forceinline__ void rwkv_scan(const Args& a, LAS unsigned char* lds, int bh, int sl) {
    const int tid = threadIdx.x; unsigned char* ws = a.ws;
    const int b = bh >> 3, h = bh & 7; const size_t m0 = (size_t)b * T; const int c0 = 64 * h;
    const float* Wd = (const float*)(ws + WS_W); const bf16* KK = (const bf16*)(ws + WS_KK); const bf16* BB = (const bf16*)(ws + WS_BB);
    const bf16* KM = (const bf16*)(ws + WS_KM); const bf16* R = (const bf16*)(ws + WS_R); const bf16* V = (const bf16*)(ws + WS_V);
    float* Y = (float*)(ws + WS_Y);
    constexpr int BUF = 5 * 16 * 64 * 4 + 16 * 16 * 4;
    constexpr int NT = T / 16;
    if (tid >= 256) {
        const int lt = tid - 256, st = lt >> 4, l16 = lt & 15, c4 = 4 * l16;
        f32x4 w; u32x2 kk, bb, km, r; bf16 v;
#define RW_LOAD(tile) do { const size_t row = m0 + (size_t)(tile) * 16 + st; const size_t o = row * 512 + c0 + c4; \
        w = *(const f32x4*)(Wd + o); kk = *(const u32x2*)(KK + o); bb = *(const u32x2*)(BB + o); km = *(const u32x2*)(KM + o); r = *(const u32x2*)(R + o); v = V[row * 512 + c0 + 16 * sl + l16]; } while (0)
#define RW_STORE(bufi) do { LAS float* B = (LAS float*)(lds + (bufi) * BUF); const int o = st * 64 + c4; \
        *(LAS f32x4*)(B + o) = w; \
        *(LAS f32x4*)(B + 1024 + o) = (f32x4){bflo(kk.x), bfhi(kk.x), bflo(kk.y), bfhi(kk.y)}; \
        *(LAS f32x4*)(B + 2048 + o) = (f32x4){bflo(bb.x), bfhi(bb.x), bflo(bb.y), bfhi(bb.y)}; \
        *(LAS f32x4*)(B + 3072 + o) = (f32x4){bflo(km.x), bfhi(km.x), bflo(km.y), bfhi(km.y)}; \
        *(LAS f32x4*)(B + 4096 + o) = (f32x4){bflo(r.x), bfhi(r.x), bflo(r.y), bfhi(r.y)}; \
        B[5120 + st * 16 + l16] = bf1(v); } while (0)
        RW_LOAD(0); RW_STORE(0); RW_LOAD(1);
        __syncthreads();
        for (int it = 0; it < NT; ++it) {
            if (it + 1 < NT) RW_STORE((it + 1) & 1);
            if (it + 2 < NT) RW_LOAD(it + 2);
            __syncthreads();
        }
#undef RW_LOAD
#undef RW_STORE
    } else {
        const int wv = tid >> 6, l = tid & 63, rloc = 4 * wv + (l >> 4), kq = l & 15;
        float S0 = 0.f, S1 = 0.f, S2 = 0.f, S3 = 0.f;
        float* yrow = Y + ((size_t)bh * 64 + 16 * sl + rloc) * T + kq;
        __syncthreads();
        for (int it = 0; it < NT; ++it) {
            const LAS float* B = (const LAS float*)(lds + (it & 1) * BUF);
            float ysel = 0.f;
#pragma unroll 4
            for (int st = 0; st < 16; ++st) {
                const int o = st * 64 + 4 * kq;
                const f32x4 w = *(const LAS f32x4*)(B + o), kk = *(const LAS f32x4*)(B + 1024 + o), bb = *(const LAS f32x4*)(B + 2048 + o), km = *(const LAS f32x4*)(B + 3072 + o), r = *(const LAS f32x4*)(B + 4096 + o);
                const float vv = B[5120 + st * 16 + rloc];
                const float p = (S0 * kk.x + S1 * kk.y) + (S2 * kk.z + S3 * kk.w);
                const float sa = -rowsum16(p);
                S0 = fmaf(S0, w.x, fmaf(sa, bb.x, vv * km.x)); S1 = fmaf(S1, w.y, fmaf(sa, bb.y, vv * km.y));
                S2 = fmaf(S2, w.z, fmaf(sa, bb.z, vv * km.z)); S3 = fmaf(S3, w.w, fmaf(sa, bb.w, vv * km.w));
                const float y = rowsum16((S0 * r.x + S1 * r.y) + (S2 * r.z + S3 * r.w));
                ysel = (kq == st) ? y : ysel;
            }
            yrow[it * 16] = ysel;
            __syncthreads();
        }
    }
}
__device__ __forceinline__ void hgrn_scan(const Args& a, LAS unsigned char* lds, int bh, int sl) {
    const int tid = threadIdx.x; unsigned char* ws = a.ws;
    const int b = bh >> 2, h = bh & 3; const size_t m0 = (size_t)b * T;
    const bf16* HG = (const bf16*)(ws + WS_HG);
    float* OH = (float*)((unsigned char*)a.out + DO_OH);
    constexpr int BUF = 2 * 16 * 128 * 4 + 16 * 16 * 4;
    constexpr int NT = T / 16;
    if (tid >= 256) {
        const int lt = tid - 256, st = lt >> 4, l16 = lt & 15, c8 = 8 * l16;
        u32x4 f, q; bf16 iv;
#define HG_LOAD(tile) do { const bf16* rp = HG + (m0 + (size_t)(tile) * 16 + st) * 2048 + 128 * h; \
        q = *(const u32x4*)(rp + c8); f = *(const u32x4*)(rp + 512 + c8); iv = rp[1024 + 16 * sl + l16]; } while (0)
#define HG_STORE(bufi) do { LAS float* B = (LAS float*)(lds + (bufi) * BUF); const int o = st * 128 + c8; \
        *(LAS f32x4*)(B + o) = (f32x4){bflo(f.x), bfhi(f.x), bflo(f.y), bfhi(f.y)}; *(LAS f32x4*)(B + o + 4) = (f32x4){bflo(f.z), bfhi(f.z), bflo(f.w), bfhi(f.w)}; \
        *(LAS f32x4*)(B + 2048 + o) = (f32x4){bflo(q.x), bfhi(q.x), bflo(q.y), bfhi(q.y)}; *(LAS f32x4*)(B + 2048 + o + 4) = (f32x4){bflo(q.z), bfhi(q.z), bflo(q.w), bfhi(q.w)}; \
        B[4096 + st * 16 + l16] = bf1(iv); } while (0)
        HG_LOAD(0); HG_STORE(0); HG_LOAD(1);
        __syncthreads();
        for (int it = 0; it < NT; ++it) {
            if (it + 1 < NT) HG_STORE((it + 1) & 1);
            if (it + 2 < NT) HG_LOAD(it + 2);
            __syncthreads();
        }
#undef HG_LOAD
#undef HG_STORE
    } else {
        const int wv = tid >> 6, l = tid & 63, rloc = 4 * wv + (l >> 4), kq = l & 15;
        float S[8];
#pragma unroll
        for (int j = 0; j < 8; ++j) S[j] = 0.f;
        float* orow = OH + ((size_t)bh * 128 + 16 * sl + rloc) * T + kq;
        __syncthreads();
        for (int it = 0; it < NT; ++it) {
            const LAS float* B = (const LAS float*)(lds + (it & 1) * BUF);
            float osel = 0.f;
#pragma unroll 4
            for (int st = 0; st < 16; ++st) {
                const int o = st * 128 + 8 * kq;
                const f32x4 f0 = *(const LAS f32x4*)(B + o), f1 = *(const LAS f32x4*)(B + o + 4), q0 = *(const LAS f32x4*)(B + 2048 + o), q1 = *(const LAS f32x4*)(B + 2048 + o + 4);
                const float iv = B[4096 + st * 16 + rloc];
#pragma unroll
                for (int j = 0; j < 4; ++j) { S[j] = fmaf(f0[j], S[j] - iv, iv); S[4 + j] = fmaf(f1[j], S[4 + j] - iv, iv); }
                float p = ((S[0] * q0.x + S[1] * q0.y) + (S[2] * q0.z + S[3] * q0.w)) + ((S[4] * q1.x + S[5] * q1.y) + (S[6] * q1.z + S[7] * q1.w));
                p = rowsum16(p);
                osel = (kq == st) ? p : osel;
            }
            orow[it * 16] = osel;
            __syncthreads();
        }
    }
}
__device__ __forceinline__ void phase3(const Args& a, LAS unsigned char* lds) {
    for (int item = blockIdx.x; item < 256; item += gridDim.x) {
        const int x = item & 7, j = item >> 3;
        __syncthreads();
        if (j < 16) rwkv_scan(a, lds, x * 4 + (j >> 2), j & 3);
        else hgrn_scan(a, lds, x * 2 + ((j - 16) >> 3), (j - 16) & 7);
    }
}

__device__ __forceinline__ void phase4(const Args& a) {
    const int tid = threadIdx.x, lane = tid & 63, wave = tid >> 6, gw = blockIdx.x * 8 + wave, NGW = gridDim.x * 8;
    unsigned char* ws = a.ws;
    bf16* MIX = (bf16*)(ws + WS_MIX);
    const float* Y = (const float*)(ws + WS_Y); const float* OH = (const float*)((unsigned char*)a.out + DO_OH);
    const bf16* R = (const bf16*)(ws + WS_R); const bf16* KM = (const bf16*)(ws + WS_KM); const bf16* V = (const bf16*)(ws + WS_V); const bf16* G = (const bf16*)((unsigned char*)a.out + DO_G);
    const bf16* HG = (const bf16*)(ws + WS_HG);
    const float* r_k = a.in[13]; const float* ln_w = a.in[14]; const float* ln_b = a.in[15]; const float* hnw = a.in[4];
    constexpr int N_RW = 32 * 128, N_HG = 16 * 128;
    for (int it = gw; it < N_RW + N_HG; it += NGW) {
        if (it < N_RW) {
            const int bh = it >> 7, tile = it & 127, b = bh >> 3, h = bh & 7, t = tile * 64 + lane; const size_t row = (size_t)b * T + t;
            const float* yp = Y + (size_t)bh * 64 * T + t;
            float y[64]; float s = 0.f;
#pragma unroll
            for (int v = 0; v < 64; ++v) { y[v] = yp[(size_t)v * T]; s += y[v]; }
            const float mu = s * (1.f / 64.f); float q = 0.f;
#pragma unroll
            for (int v = 0; v < 64; ++v) { const float d = y[v] - mu; q += d * d; }
            const float rs = __builtin_amdgcn_rsqf(q * (1.f / 64.f) + 64e-5f);
            const size_t o = row * 512 + 64 * h;
            float dot = 0.f;
#pragma unroll
            for (int ch = 0; ch < 8; ++ch) {
                const u32x4 rr = *(const u32x4*)(R + o + 8 * ch), kk = *(const u32x4*)(KM + o + 8 * ch);
                const f32x4 k0 = *(const f32x4*)(r_k + 64 * h + 8 * ch), k1 = *(const f32x4*)(r_k + 64 * h + 8 * ch + 4);
                dot += bflo(rr.x) * bflo(kk.x) * k0.x + bfhi(rr.x) * bfhi(kk.x) * k0.y + bflo(rr.y) * bflo(kk.y) * k0.z + bfhi(rr.y) * bfhi(kk.y) * k0.w
                     + bflo(rr.z) * bflo(kk.z) * k1.x + bfhi(rr.z) * bfhi(kk.z) * k1.y + bflo(rr.w) * bflo(kk.w) * k1.z + bfhi(rr.w) * bfhi(kk.w) * k1.w;
            }
#pragma unroll
            for (int ch = 0; ch < 8; ++ch) {
                const u32x4 vv = *(const u32x4*)(V + o + 8 * ch), gg = *(const u32x4*)(G + o + 8 * ch);
                const f32x4 w0 = *(const f32x4*)(ln_w + 64 * h + 8 * ch), w1 = *(const f32x4*)(ln_w + 64 * h + 8 * ch + 4), b0 = *(const f32x4*)(ln_b + 64 * h + 8 * ch), b1 = *(const f32x4*)(ln_b + 64 * h + 8 * ch + 4);
                float e[8];
                e[0] = ((y[8 * ch + 0] - mu) * rs * w0.x + b0.x + dot * bflo(vv.x)) * bflo(gg.x); e[1] = ((y[8 * ch + 1] - mu) * rs * w0.y + b0.y + dot * bfhi(vv.x)) * bfhi(gg.x);
                e[2] = ((y[8 * ch + 2] - mu) * rs * w0.z + b0.z + dot * bflo(vv.y)) * bflo(gg.y); e[3] = ((y[8 * ch + 3] - mu) * rs * w0.w + b0.w + dot * bfhi(vv.y)) * bfhi(gg.y);
                e[4] = ((y[8 * ch + 4] - mu) * rs * w1.x + b1.x + dot * bflo(vv.z)) * bflo(gg.z); e[5] = ((y[8 * ch + 5] - mu) * rs * w1.y + b1.y + dot * bfhi(vv.z)) * bfhi(gg.z);
                e[6] = ((y[8 * ch + 6] - mu) * rs * w1.z + b1.z + dot * bflo(vv.w)) * bflo(gg.w); e[7] = ((y[8 * ch + 7] - mu) * rs * w1.w + b1.w + dot * bfhi(vv.w)) * bfhi(gg.w);
                u32x4 ov; ov.x = pk2(e[0], e[1]); ov.y = pk2(e[2], e[3]); ov.z = pk2(e[4], e[5]); ov.w = pk2(e[6], e[7]);
                *(u32x4*)(MIX + row * 1024 + 512 + 64 * h + 8 * ch) = ov;
            }
        } else {
            const int i2 = it - N_RW, bh = i2 >> 7, tile = i2 & 127, b = bh >> 2, h = bh & 3, t = tile * 64 + lane; const size_t row = (size_t)b * T + t;
            const float* op = OH + (size_t)bh * 128 * T + t;
            float ss = 0.f;
#pragma unroll 16
            for (int v = 0; v < 128; ++v) { const float o = op[(size_t)v * T]; ss += o * o; }
            const float rs = __builtin_amdgcn_rsqf(ss * (1.f / 128.f) + 1e-6f);
            const bf16* gp = HG + row * 2048 + 1536 + 128 * h;
#pragma unroll 2
            for (int ch = 0; ch < 16; ++ch) {
                const u32x4 gg = *(const u32x4*)(gp + 8 * ch);
                const f32x4 w0 = *(const f32x4*)(hnw + 128 * h + 8 * ch), w1 = *(const f32x4*)(hnw + 128 * h + 8 * ch + 4);
                float gv[8] = {bflo(gg.x), bfhi(gg.x), bflo(gg.y), bfhi(gg.y), bflo(gg.z), bfhi(gg.z), bflo(gg.w), bfhi(gg.w)};
                float wv[8] = {w0.x, w0.y, w0.z, w0.w, w1.x, w1.y, w1.z, w1.w};
                float e[8];
#pragma unroll
                for (int j = 0; j < 8; ++j) e[j] = op[(size_t)(8 * ch + j) * T] * rs * wv[j] * gv[j] * sigmf(gv[j]);
                u32x4 ov; ov.x = pk2(e[0], e[1]); ov.y = pk2(e[2], e[3]); ov.z = pk2(e[4], e[5]); ov.w = pk2(e[6], e[7]);
                *(u32x4*)(MIX + row * 1024 + 128 * h + 8 * ch) = ov;
            }
        }
    }
}

__device__ __forceinline__ void phase8(const Args& a) {
    const int tid = threadIdx.x, lane = tid & 63, wave = tid >> 6, gw = blockIdx.x * 8 + wave, NGW = gridDim.x * 8;
    const float* fw = a.in[21]; const float* ssq = (const float*)(a.ws + WS_SSQ2);
    f32x4 wv[4];
#pragma unroll
    for (int j = 0; j < 4; ++j) wv[j] = *((const f32x4*)fw + 64 * j + lane);
    for (int m = gw; m < M; m += NGW) {
        const float rstd = __builtin_amdgcn_rsqf(ssq[m] * (1.f / D) + 1e-6f);
        f32x4* xr = (f32x4*)(a.out + (size_t)m * D) + lane;
#pragma unroll
        for (int j = 0; j < 4; ++j) { f32x4 v = xr[64 * j]; v = v * rstd * wv[j]; xr[64 * j] = v; }
    }
}

__global__ void __launch_bounds__(512, 2) fwd_kernel(Args a) {
    extern __shared__ __attribute__((aligned(16))) unsigned char lds_raw[];
    LAS unsigned char* lds = (LAS unsigned char*)lds_raw;
    cg::grid_group grid = cg::this_grid();
    unsigned char* ws = a.ws;
    const int lo = a.ph_lo, hi = a.ph_hi;
#define IN(k) (lo <= (k) && (k) < hi)
#define SEAM(k) do { if ((k) + 1 < hi) grid.sync(); } while (0)
    {
        if (IN(0)) { phase0(a, lds); SEAM(0); }
        if (IN(1)) {
            pg8::Gemm g{(const pg8::bf16_t*)((unsigned char*)a.out + DO_XN), (const pg8::bf16_t*)(ws + WS_WTIN), M, 3840, 1024}; pg8::StaticOrder S; S.init(M, 3840, gridDim.x, blockIdx.x);
            pg8::EpiProj E{(pg8::bf16_t*)(ws + WS_HG), (pg8::bf16_t*)(ws + WS_RW), (const float*)(ws + WS_LB)};
            pg8::gemm_phase<pg8::EpiProj, pg8::StaticOrder>((PG8_LAS unsigned char*)lds, g, S, E, nullptr); SEAM(1);
        }
        if (IN(2)) { phase2(a, lds); SEAM(2); }
        if (IN(3)) { phase3(a, lds); SEAM(3); }
        if (IN(4)) { phase4(a); SEAM(4); }
        if (IN(5)) {
            pg8::Gemm g{(const pg8::bf16_t*)(ws + WS_MIX), (const pg8::bf16_t*)(ws + WS_WTOUT), M, 1024, 1024}; pg8::StaticOrder S; S.init(M, 1024, gridDim.x, blockIdx.x);
            pg8::EpiRes<true> E{a.in[0], a.out, (pg8::bf16_t*)(ws + WS_X1B), a.in[17], (float*)(ws + WS_SSQ1)};
            pg8::gemm_phase<pg8::EpiRes<true>, pg8::StaticOrder>((PG8_LAS unsigned char*)lds, g, S, E, nullptr); SEAM(5);
        }
        if (IN(6)) {
            pg8::Gemm g{(const pg8::bf16_t*)(ws + WS_X1B), (const pg8::bf16_t*)(ws + WS_WT13), M, 2 * FF, 1024}; pg8::StaticOrder S; S.init(M, 2 * FF, gridDim.x, blockIdx.x);
            pg8::EpiGlu E{(pg8::bf16_t*)(ws + WS_U), (const float*)(ws + WS_SSQ1)};
            pg8::gemm_phase<pg8::EpiGlu, pg8::StaticOrder>((PG8_LAS unsigned char*)lds, g, S, E, nullptr); SEAM(6);
        }
        if (IN(7)) {
            pg8::Gemm g{(const pg8::bf16_t*)(ws + WS_U), (const pg8::bf16_t*)(ws + WS_WT2), M, 1024, FF}; pg8::StaticOrder S; S.init(M, 1024, gridDim.x, blockIdx.x);
            pg8::EpiRes<false> E{a.out, a.out, nullptr, nullptr, (float*)(ws + WS_SSQ2)};
            pg8::gemm_phase<pg8::EpiRes<false>, pg8::StaticOrder>((PG8_LAS unsigned char*)lds, g, S, E, nullptr); SEAM(7);
        }
        if (IN(8)) phase8(a);
    }
#undef IN
#undef SEAM
}

extern "C" void kernel_launch(void* const* d_in, const int* in_sizes, int n_in, void* d_out, int out_size, void* d_ws, size_t ws_size, hipStream_t stream) {
    static int grid = 0;
    if (grid == 0) {
        if (n_in != 22 || out_size != M * D || ws_size < WS_END) { fprintf(stderr, "kernel_launch: unexpected problem (n_in %d, out %d, ws %zu)\n", n_in, out_size, ws_size); grid = -1; return; }
        int dev = 0, cus = 0, per_cu = 0;
        if (hipGetDevice(&dev) != hipSuccess || hipDeviceGetAttribute(&cus, hipDeviceAttributeMultiprocessorCount, dev) != hipSuccess) { grid = -1; return; }
        if (hipFuncSetAttribute((const void*)fwd_kernel, hipFuncAttributeMaxDynamicSharedMemorySize, LDS_BYTES) != hipSuccess) { fprintf(stderr, "kernel_launch: hipFuncSetAttribute failed\n"); grid = -1; return; }
        if (hipOccupancyMaxActiveBlocksPerMultiprocessor(&per_cu, (const void*)fwd_kernel, 512, LDS_BYTES) != hipSuccess || per_cu < 1) { fprintf(stderr, "kernel_launch: occupancy query says %d\n", per_cu); per_cu = 1; }
        (void)hipGetLastError();
        grid = cus * 1;
    }
    if (grid < 0) return;
    Args a{};
    for (int i = 0; i < 22; ++i) a.in[i] = (const float*)d_in[i];
    a.out = (float*)d_out; a.ws = (unsigned char*)d_ws;
    if (N_LAUNCHES == 1) {
        a.ph_lo = 0; a.ph_hi = NPHASE;
        void* args[] = {&a};
        hipError_t e = hipLaunchCooperativeKernel((const void*)fwd_kernel, dim3(grid), dim3(512), args, LDS_BYTES, stream);
        if (e != hipSuccess) fprintf(stderr, "cooperative launch failed: %s (grid %d)\n", hipGetErrorString(e), grid);
    } else {
        for (int ph = 0; ph < NPHASE; ++ph) { a.ph_lo = ph; a.ph_hi = ph + 1; hipLaunchKernelGGL(fwd_kernel, dim3(grid), dim3(512), LDS_BYTES, stream, a); }
    }
}
```

```cpp
#include <hip/hip_runtime.h>
#include <hip/hip_cooperative_groups.h>
#include <cstdio>
namespace cg = cooperative_groups;
namespace pg8 {
#define PG8_LAS __attribute__((address_space(3)))
typedef unsigned short bf16_t;
typedef short bf16x8 __attribute__((ext_vector_type(8)));
typedef float f32x4 __attribute__((ext_vector_type(4)));
typedef unsigned u32x4 __attribute__((ext_vector_type(4)));
constexpr int BM = 256, BK = 64, HALF = 128, HTB = HALF * BK * 2  , STAGE_BYTES = 8 * HTB, NXCD = 8, WGM = 8;

__host__ __device__ __forceinline__ int lds_byte(int r, int c) { const int st = (r >> 4) * 2 + (c >> 5), rr = r & 15, cc = c & 31, ob = rr * 64 + cc * 2; return st * 1024 + (ob ^ (((ob >> 9) & 1) << 5)); }
__host__ __device__ __forceinline__ void stage_rc(int b, int& R, int& C) { const int st = b / 1024, sb = b % 1024, swz = sb ^ (((sb >> 9) & 1) << 5); R = (st >> 1) * 16 + swz / 64; C = (st & 1) * 32 + (swz % 64) / 2; }
__host__ __device__ __forceinline__ int perm32(int rho) { const int n = rho >> 4, i = rho & 15; return 8 * (i >> 2) + 4 * n + (i & 3); }

struct Unit { int pm, pn; };
struct Gemm { const bf16_t* A; const bf16_t* Bt; int M, N, K; };

struct StaticOrder {
    int nM, nN, nwg, G, c;
    __host__ __device__ void init(int M, int N, int G_, int c_) { nM = M / BM; nN = N / BM; nwg = nM * nN; G = G_; c = c_; }
    __host__ __device__ bool next(int i, Unit& u) const {
        const long L = (long)i * G + c; if (L >= nwg) return false;
        int wgid = (int)L; { const int q = nwg / NXCD, r = nwg % NXCD, xcd = wgid % NXCD, off = wgid / NXCD; wgid = (xcd < r ? xcd * (q + 1) : r * (q + 1) + (xcd - r) * q) + off; }
        const int nig = WGM * nN, gid = wgid / nig, fm = gid * WGM, gsz = (nM - fm) < WGM ? (nM - fm) : WGM;
        u.pm = fm + ((wgid % nig) % gsz); u.pn = (wgid % nig) / gsz; return true;
    }
    __device__ __forceinline__ void a_ready(const Unit&) const {}
    __device__ __forceinline__ void done(const Unit&) const {}
};
__device__ __forceinline__ unsigned cvt_pk_bf16(float lo, float hi) { unsigned r; asm volatile("v_cvt_pk_bf16_f32 %0, %1, %2" : "=v"(r) : "v"(lo), "v"(hi)); return r; }
__device__ __forceinline__ float sigm(float v) { return __builtin_amdgcn_rcpf(1.0f + __expf(-v)); }
struct EpiProj {
    static constexpr bool PERM = true, AFTER_DRAIN = false;
    bf16_t* HG; bf16_t* RW; const float* LB;
    __device__ __forceinline__ void operator()(const f32x4 (&acc)[2][2][4][2], const Unit& u, int wr, int wc, int fr, int fq) const {
        const int row0 = u.pm * BM + wr * 64 + fr, cb = u.pn * BM + wc * 32 + 8 * fq;
        const int mode = u.pn < 2 ? 0 : (u.pn < 4 ? 1 : 2);
#pragma unroll
        for (int bj = 0; bj < 2; ++bj) {
            const int col = cb + bj * HALF;
            f32x4 l0 = (f32x4){0.f, 0.f, 0.f, 0.f}, l1 = l0;
            if (mode == 1) { l0 = *(const f32x4*)(LB + col - 512); l1 = *(const f32x4*)(LB + col - 512 + 4); }
#pragma unroll
            for (int ai = 0; ai < 2; ++ai)
#pragma unroll
                for (int m = 0; m < 4; ++m) {
                    const int row = row0 + ai * HALF + m * 16;
                    f32x4 v0 = acc[ai][bj][m][0], v1 = acc[ai][bj][m][1];
                    if (mode == 0) {
#pragma unroll
                        for (int j = 0; j < 4; ++j) { v0[j] = v0[j] * sigm(v0[j]); v1[j] = v1[j] * sigm(v1[j]); }
                    } else if (mode == 1) {
#pragma unroll
                        for (int j = 0; j < 4; ++j) { v0[j] = l0[j] + (1.0f - l0[j]) * sigm(v0[j]); v1[j] = l1[j] + (1.0f - l1[j]) * sigm(v1[j]); }
                    }
                    u32x4 w; w.x = cvt_pk_bf16(v0[0], v0[1]); w.y = cvt_pk_bf16(v0[2], v0[3]); w.z = cvt_pk_bf16(v1[0], v1[1]); w.w = cvt_pk_bf16(v1[2], v1[3]);
                    bf16_t* dst = (u.pn < 8) ? HG + (size_t)row * 2048 + col : RW + (size_t)row * 1792 + (col - 2048);
                    *(u32x4*)dst = w;
                }
        }
    }
};
template <bool WB> struct EpiRes {
    static constexpr bool PERM = true, AFTER_DRAIN = false;
    const float* X; float* X1; bf16_t* X1B; const float* NW; float* SSQ;
    __device__ __forceinline__ void operator()(const f32x4 (&acc)[2][2][4][2], const Unit& u, int wr, int wc, int fr, int fq) const {
        const int row0 = u.pm * BM + wr * 64 + fr, cb = u.pn * BM + wc * 32 + 8 * fq;
#pragma unroll
        for (int ai = 0; ai < 2; ++ai)
#pragma unroll
            for (int m = 0; m < 4; ++m) {
                const int row = row0 + ai * HALF + m * 16; float ss = 0.f;
#pragma unroll
                for (int bj = 0; bj < 2; ++bj) {
                    const size_t off = (size_t)row * 1024 + cb + bj * HALF;
                    f32x4 v0 = acc[ai][bj][m][0] + *(const f32x4*)(X + off), v1 = acc[ai][bj][m][1] + *(const f32x4*)(X + off + 4);
                    *(f32x4*)(X1 + off) = v0; *(f32x4*)(X1 + off + 4) = v1;
                    ss += (v0[0] * v0[0] + v0[1] * v0[1]) + (v0[2] * v0[2] + v0[3] * v0[3]) + (v1[0] * v1[0] + v1[1] * v1[1]) + (v1[2] * v1[2] + v1[3] * v1[3]);
                    if (WB) { const f32x4 n0 = *(const f32x4*)(NW + cb + bj * HALF), n1 = *(const f32x4*)(NW + cb + bj * HALF + 4);
                        u32x4 w; w.x = cvt_pk_bf16(v0[0] * n0[0], v0[1] * n0[1]); w.y = cvt_pk_bf16(v0[2] * n0[2], v0[3] * n0[3]); w.z = cvt_pk_bf16(v1[0] * n1[0], v1[1] * n1[1]); w.w = cvt_pk_bf16(v1[2] * n1[2], v1[3] * n1[3]);
                        *(u32x4*)(X1B + off) = w; }
                }
                ss += __shfl_xor(ss, 16); ss += __shfl_xor(ss, 32);
                if (fq == 0) unsafeAtomicAdd(SSQ + row, ss);
            }
    }
};
struct EpiGlu {
    static constexpr bool PERM = true, AFTER_DRAIN = false;
    bf16_t* U; const float* SSQ;
    __device__ __forceinline__ void operator()(const f32x4 (&acc)[2][2][4][2], const Unit& u, int wr, int wc, int fr, int fq) const {
        const int row0 = u.pm * BM + wr * 64 + fr, cb = (u.pn * BM + wc * 32 + 8 * fq) >> 1;
#pragma unroll
        for (int ai = 0; ai < 2; ++ai)
#pragma unroll
            for (int m = 0; m < 4; ++m) {
                const int row = row0 + ai * HALF + m * 16;
                const float rstd = __builtin_amdgcn_rsqf(SSQ[row] * (1.0f / 1024.0f) + 1e-6f);
#pragma unroll
                for (int bj = 0; bj < 2; ++bj) {
                    const f32x4 g = acc[ai][bj][m][0] * rstd, up = acc[ai][bj][m][1] * rstd; float h[4];
#pragma unroll
                    for (int j = 0; j < 4; ++j) h[j] = g[j] * sigm(g[j]) * up[j];
                    typedef unsigned u32x2 __attribute__((ext_vector_type(2)));
                    u32x2 w; w.x = cvt_pk_bf16(h[0], h[1]); w.y = cvt_pk_bf16(h[2], h[3]);
                    *(u32x2*)(U + (size_t)row * 2816 + cb + bj * (HALF / 2)) = w;
                }
            }
    }
};

template <class Epi, class Sched, bool STAMP = false>
__device__ __forceinline__ void gemm_phase(PG8_LAS unsigned char* lds, const Gemm g, const Sched& S, const Epi& E, unsigned long long* stamps) {
    const int tid = threadIdx.x, wid = __builtin_amdgcn_readfirstlane(tid >> 6), lane = tid & 63, wr = wid >> 2, wc = wid & 3, fr = lane & 15, fq = lane >> 4;
    const int K = g.K, nt = K / BK;
    int ts_lo = 0, ts_hi = 0, nts = 0; const unsigned long long rt_entry = STAMP ? (unsigned long long)wall_clock64() : 0ull;
#define PG8_STAMP() do { if (STAMP && wid == 0 && nts < 64) { const unsigned long long _c = (unsigned long long)clock64(); \
        ts_lo = (lane == nts) ? (int)(unsigned)_c : ts_lo; ts_hi = (lane == nts) ? (int)(unsigned)(_c >> 32) : ts_hi; ++nts; } } while (0)
    PG8_STAMP();
    unsigned voffA[2], voffB[2];
#pragma unroll
    for (int i = 0; i < 2; ++i) { int R, C; stage_rc(tid * 16 + i * 8192, R, C); const int Rb = Epi::PERM ? ((R & ~31) + perm32(R & 31)) : R;
        voffA[i] = (unsigned)(R * K + C) * 2u; voffB[i] = (unsigned)(Rb * K + C) * 2u; }
    const size_t kstep = (size_t)(BK * 2);
    const size_t hstep = (size_t)HALF * K * 2;
    const size_t tstep = 2 * hstep;
    const unsigned ldsw = (unsigned)wid * 1024u;
    const int aoff = lds_byte(wr * 64 + fr, fq * 8), boff = lds_byte(wc * 32 + fr, fq * 8);
#define PG8_SA(b, h) (((b) * 2 + (h)) * HTB)
#define PG8_SB(b, h) ((4 + (b) * 2 + (h)) * HTB)
#define PG8_STAGE(bufoff, gbase, voff) do { _Pragma("unroll") for (int _i = 0; _i < 2; ++_i) \
        __builtin_amdgcn_global_load_lds((const unsigned*)((const char*)(gbase) + (voff)[_i]), (PG8_LAS unsigned*)(lds + (bufoff) + ldsw + _i * 8192), 16, 0, 0); } while (0)
#define PG8_LDA(dst, b, h) do { _Pragma("unroll") for (int m = 0; m < 4; ++m) _Pragma("unroll") for (int k = 0; k < 2; ++k) dst[m][k] = *(const PG8_LAS bf16x8*)(lds + PG8_SA(b, h) + aoff + m * 2048 + k * 1024); } while (0)
#define PG8_LDB(dst, b, h) do { _Pragma("unroll") for (int n = 0; n < 2; ++n) _Pragma("unroll") for (int k = 0; k < 2; ++k) dst[n][k] = *(const PG8_LAS bf16x8*)(lds + PG8_SB(b, h) + boff + n * 2048 + k * 1024); } while (0)
#define PG8_MMA(ai, bj, At, Bt) do { __builtin_amdgcn_s_setprio(1); _Pragma("unroll") for (int m = 0; m < 4; ++m) _Pragma("unroll") for (int n = 0; n < 2; ++n) _Pragma("unroll") for (int k = 0; k < 2; ++k) \
        acc[ai][bj][m][n] = __builtin_amdgcn_mfma_f32_16x16x32_bf16(Bt[n][k], At[m][k], acc[ai][bj][m][n], 0, 0, 0); __builtin_amdgcn_s_setprio(0); } while (0)
#define PG8_WAIT_V(n) asm volatile("s_waitcnt vmcnt(" #n ")" ::: "memory")
#define PG8_WAIT_L(n) asm volatile("s_waitcnt lgkmcnt(" #n ")" ::: "memory")
#define PG8_BAR __builtin_amdgcn_s_barrier()
#define PG8_SCHED __builtin_amdgcn_sched_barrier(0)
    Unit cur, nxt; int ui = 0;
    if (!S.next(0, cur)) return;
    f32x4 acc[2][2][4][2];
#pragma unroll
    for (int a = 0; a < 2; ++a)
#pragma unroll
        for (int b = 0; b < 2; ++b)
#pragma unroll
            for (int m = 0; m < 4; ++m)
#pragma unroll
                for (int n = 0; n < 2; ++n) acc[a][b][m][n] = (f32x4){0.f, 0.f, 0.f, 0.f};
    bf16x8 At[4][2], B0[2][2], B1[2][2];
    const char* cA = (const char*)g.A + (size_t)cur.pm * tstep; const char* cB = (const char*)g.Bt + (size_t)cur.pn * tstep;
    S.a_ready(cur);
    PG8_STAGE(PG8_SB(0, 0), cB, voffB); PG8_STAGE(PG8_SA(0, 0), cA, voffA); PG8_STAGE(PG8_SB(0, 1), cB + hstep, voffB); PG8_STAGE(PG8_SA(0, 1), cA + hstep, voffA);
    if (wr == 1) PG8_BAR;
    PG8_WAIT_V(4); PG8_BAR;
    PG8_STAGE(PG8_SB(1, 0), cB + kstep, voffB); PG8_STAGE(PG8_SA(1, 0), cA + kstep, voffA); PG8_STAGE(PG8_SB(1, 1), cB + hstep + kstep, voffB);
    PG8_WAIT_V(6); PG8_BAR;
    PG8_STAMP();
    for (;;) {
        const bool has_next = S.next(ui + 1, nxt);
        const char* nA = has_next ? (const char*)g.A + (size_t)nxt.pm * tstep : cA; const char* nB = has_next ? (const char*)g.Bt + (size_t)nxt.pn * tstep : cB;
        for (int t = 0; t < nt; t += 2) {
            const bool last = (t == nt - 2);
            const char* a1 = cA + (size_t)(t + 1) * kstep;
            const char* a2 = last ? nA : cA + (size_t)(t + 2) * kstep; const char* b2 = last ? nB : cB + (size_t)(t + 2) * kstep;
            const char* a3 = a2 + kstep; const char* b3 = b2 + kstep;
            if (last && has_next) S.a_ready(nxt);
            PG8_LDB(B0, 0, 0); PG8_SCHED; PG8_LDA(At, 0, 0); PG8_STAGE(PG8_SA(1, 1), a1 + hstep, voffA);
            PG8_WAIT_L(8); PG8_BAR; PG8_WAIT_L(0); PG8_MMA(0, 0, At, B0); PG8_BAR; PG8_SCHED;
            PG8_LDB(B1, 0, 1); PG8_STAGE(PG8_SB(0, 0), b2, voffB);
            PG8_BAR; PG8_WAIT_L(0); PG8_MMA(0, 1, At, B1); PG8_BAR;
            PG8_LDA(At, 0, 1); PG8_STAGE(PG8_SA(0, 0), a2, voffA);
            PG8_BAR; PG8_WAIT_L(0); PG8_MMA(1, 0, At, B0); PG8_BAR; PG8_SCHED;
            PG8_STAGE(PG8_SB(0, 1), b2 + hstep, voffB);
            PG8_WAIT_V(6); PG8_BAR; PG8_MMA(1, 1, At, B1); PG8_BAR;
            PG8_LDB(B0, 1, 0); PG8_SCHED; PG8_LDA(At, 1, 0); PG8_STAGE(PG8_SA(0, 1), a2 + hstep, voffA);
            PG8_WAIT_L(8); PG8_BAR; PG8_WAIT_L(0); PG8_MMA(0, 0, At, B0); PG8_BAR; PG8_SCHED;
            PG8_LDB(B1, 1, 1); PG8_STAGE(PG8_SB(1, 0), b3, voffB);
            PG8_BAR; PG8_WAIT_L(0); PG8_MMA(0, 1, At, B1); PG8_BAR;
            PG8_LDA(At, 1, 1); PG8_STAGE(PG8_SA(1, 0), a3, voffA);
            PG8_BAR; PG8_WAIT_L(0); PG8_MMA(1, 0, At, B0); PG8_BAR; PG8_SCHED;
            PG8_STAGE(PG8_SB(1, 1), b3 + hstep, voffB);
            PG8_WAIT_V(6); PG8_BAR; PG8_MMA(1, 1, At, B1); PG8_BAR;
        }
        PG8_STAMP();
        if constexpr (!Epi::AFTER_DRAIN) { E(acc, cur, wr, wc, fr, fq); S.done(cur); }
        PG8_STAMP();
        if (!has_next) break;
#pragma unroll
        for (int a = 0; a < 2; ++a)
#pragma unroll
            for (int b = 0; b < 2; ++b)
#pragma unroll
                for (int m = 0; m < 4; ++m)
#pragma unroll
                    for (int n = 0; n < 2; ++n) acc[a][b][m][n] = (f32x4){0.f, 0.f, 0.f, 0.f};
        cur = nxt; cA = nA; cB = nB; ++ui;
    }
    PG8_WAIT_V(0);
    if (wr == 0) PG8_BAR;
    PG8_BAR;
    if constexpr (Epi::AFTER_DRAIN) { E.fused(acc, cur, wr, wc, fr, fq, lds, wid, lane); S.done(cur); }
    PG8_STAMP();
    if (STAMP && wid == 0) { stamps[lane] = lane < nts ? (((unsigned long long)(unsigned)ts_hi << 32) | (unsigned)ts_lo) : 0ull;
        if (lane == 62) stamps[62] = rt_entry; if (lane == 63) stamps[63] = (unsigned long long)wall_clock64(); }
#undef PG8_STAMP
#undef PG8_SA
#undef PG8_SB
#undef PG8_STAGE
#undef PG8_LDA
#undef PG8_LDB
#undef PG8_MMA
#undef PG8_WAIT_V
#undef PG8_WAIT_L
#undef PG8_BAR
#undef PG8_SCHED
}
}
#define LAS __attribute__((address_space(3)))
typedef unsigned short bf16;
typedef float f32x4 __attribute__((ext_vector_type(4)));
typedef unsigned u32x4 __attribute__((ext_vector_type(4)));
typedef unsigned u32x2 __attribute__((ext_vector_type(2)));
typedef float f32x2 __attribute__((ext_vector_type(2)));
typedef short bf16x8 __attribute__((ext_vector_type(8)));
constexpr int M = 32768, T = 8192, D = 1024, FF = 2816;
constexpr size_t MiB = 1u << 20;
constexpr size_t WS_LB = 0, WS_SSQ1 = 65536, WS_SSQ2 = 65536 + 131072;
constexpr size_t WS_WTIN = 2 * MiB, WS_WTOUT = 10 * MiB, WS_WT13 = 12 * MiB, WS_WT2 = 23 * MiB, WS_LT = 29 * MiB;
constexpr size_t WS_HG = 32 * MiB, WS_RW = 160 * MiB, WS_Y = 160 * MiB, WS_W = 272 * MiB, WS_KK = 336 * MiB, WS_BB = 368 * MiB, WS_KM = 400 * MiB, WS_R = 432 * MiB, WS_V = 464 * MiB;
constexpr size_t WS_MIX = 336 * MiB, WS_X1B = 272 * MiB, WS_U = 32 * MiB, WS_END = 496 * MiB;
constexpr size_t DO_XN = 0, DO_G = 0, DO_OH = 32 * MiB;
constexpr int LDS_BYTES = 147456;
constexpr int NPHASE = 9;
#ifndef N_LAUNCHES
#define N_LAUNCHES 1
#endif

__device__ __forceinline__ unsigned f2bf(float f) { unsigned u = __float_as_uint(f); return (u + 0x7fffu + ((u >> 16) & 1u)) >> 16; }
__device__ __forceinline__ unsigned pk2(float lo, float hi) { return f2bf(lo) | (f2bf(hi) << 16); }
__device__ __forceinline__ float bflo(unsigned u) { return __uint_as_float(u << 16); }
__device__ __forceinline__ float bfhi(unsigned u) { return __uint_as_float(u & 0xffff0000u); }
__device__ __forceinline__ float bf1(bf16 b) { return __uint_as_float(((unsigned)b) << 16); }
__device__ __forceinline__ float sigmf(float v) { return __builtin_amdgcn_rcpf(1.0f + __expf(-v)); }
__device__ __forceinline__ float wave_sum(float v) {
#pragma unroll
    for (int o = 1; o < 64; o <<= 1) v += __shfl_xor(v, o);
    return v;
}
template <int CTRL> __device__ __forceinline__ float dpp_add(float v) { return v + __int_as_float(__builtin_amdgcn_update_dpp(0, __float_as_int(v), CTRL, 0xf, 0xf, true)); }
__device__ __forceinline__ float rowsum16(float v) { v = dpp_add<0xB1>(v); v = dpp_add<0x4E>(v); v = dpp_add<0x141>(v); v = dpp_add<0x140>(v); return v; }

#define XB_TMO      128
#define XB_XCNT(j)  (256  + 64 * (j))
#define XB_XSUB(j)  (1280 + 64 * (j))
#define XB_XGEN(j)  (2304 + 64 * (j))
#define XB_TOP      3328
#define XB_TOPGEN   3392
#define XCD_BAR_WORDS 3456
#define XB_SPIN_CAP (1u << 18)

__device__ __forceinline__ unsigned xb_ld(unsigned* p)              { return __hip_atomic_load(p, __ATOMIC_RELAXED, __HIP_MEMORY_SCOPE_AGENT); }
__device__ __forceinline__ unsigned xb_add(unsigned* p, unsigned v) { return __hip_atomic_fetch_add(p, v, __ATOMIC_RELAXED, __HIP_MEMORY_SCOPE_AGENT); }
__device__ __forceinline__ unsigned xb_xcc_id() { return (unsigned)__builtin_amdgcn_s_getreg((3 << 11) | 20) & 0xFu; }
#define XB_SPIN(cond, bar) do { unsigned _sp = 0; while (cond) { __builtin_amdgcn_s_sleep(1); \
    if ((++_sp & 255u) == 0u) { if (xb_ld(&(bar)[XB_TMO])) break; if (_sp > XB_SPIN_CAP) { atomicAdd(&(bar)[XB_TMO], 1u); break; } } } } while (0)

struct XcdBarrier {
    unsigned* bar; unsigned x;
    volatile LAS unsigned* st;
};

__device__ __forceinline__ XcdBarrier xcd_barrier_post(unsigned* bar, volatile LAS unsigned* st) {
    XcdBarrier b; b.bar = bar; b.x = xb_xcc_id(); b.st = st;
    if (threadIdx.x == 0) (void)xb_add(&bar[XB_XCNT(b.x)], 1u);
    return b;
}
__device__ __forceinline__ void xcd_barrier_complete(unsigned* bar, unsigned x, unsigned& nloc, unsigned& nx) {
    const unsigned G = gridDim.x * gridDim.y * gridDim.z;
    unsigned sum, cnt, mine, sp = 0u;
    for (;;) {
        sum = 0u; cnt = 0u; mine = 0u;
#pragma unroll
        for (unsigned j = 0; j < 16; ++j) { const unsigned c = xb_ld(&bar[XB_XCNT(j)]); sum += c; cnt += (c > 0u) ? 1u : 0u; mine = (j == x) ? c : mine; }
        if (sum == G) break;
        __builtin_amdgcn_s_sleep(1);
        if ((++sp & 255u) == 0u) { if (xb_ld(&bar[XB_TMO])) break; if (sp > XB_SPIN_CAP) { atomicAdd(&bar[XB_TMO], 1u); break; } }
    }
    nloc = mine > 0u ? mine : 1u; nx = cnt > 0u ? cnt : 1u;
}

__device__ __forceinline__ void xcd_barrier(const XcdBarrier& b) {
    asm volatile("s_waitcnt vmcnt(0)" ::: "memory");
    __syncthreads();
    if (threadIdx.x == 0) {
        unsigned* bar = b.bar;
        __builtin_amdgcn_s_waitcnt(0);
        unsigned nloc = b.st[0], nx = b.st[1];
        if (nloc == 0u) { xcd_barrier_complete(bar, b.x, nloc, nx); b.st[0] = nloc; b.st[1] = nx; }
        const unsigned old = xb_add(&bar[XB_XSUB(b.x)], 1u);
        const unsigned gen = old / nloc;
        if (old + 1u == (gen + 1u) * nloc) {
            __builtin_amdgcn_fence(__ATOMIC_RELEASE, "agent");
            asm volatile("s_waitcnt vmcnt(0)" ::: "memory");
            const unsigned og = xb_add(&bar[XB_TOP], 1u);
            const unsigned tg = og / nx;
            if (og + 1u == (tg + 1u) * nx) xb_add(&bar[XB_TOPGEN], 1u);
            else XB_SPIN(xb_ld(&bar[XB_TOPGEN]) == tg, bar);
            __builtin_amdgcn_fence(__ATOMIC_ACQUIRE, "agent");
            xb_add(&bar[XB_XGEN(b.x)], 1u);
            asm volatile("s_waitcnt vmcnt(0)" ::: "memory");
        } else {
            XB_SPIN(xb_ld(&bar[XB_XGEN(b.x)]) == gen, bar);
            __builtin_amdgcn_fence(__ATOMIC_ACQUIRE, "agent");
            asm volatile("s_waitcnt vmcnt(0)" ::: "memory");
        }
    }
    __syncthreads();
}

constexpr size_t WS_BAR = 524288;
struct Args { const float* in[22]; float* out; unsigned char* ws; int ph_lo, ph_hi; };

__device__ __forceinline__ void p0_transpose_item(const float* W, int K, int N, bf16* WT, int ld, int koff, int mode, LAS float* scr, int item, int lane) {
    const int nblk = N / 32, kb = item / nblk, nb = item % nblk, k0 = 64 * kb, n0 = 32 * nb;
#pragma unroll 8
    for (int i = 0; i < 32; ++i) { const int kk = 2 * i + (lane >> 5); scr[kk * 33 + (lane & 31)] = W[(size_t)(k0 + kk) * N + n0 + (lane & 31)]; }
    asm volatile("s_waitcnt lgkmcnt(0)" ::: "memory");
    const int c = lane & 7;
#pragma unroll
    for (int j = 0; j < 4; ++j) { const int n = (lane >> 3) + 8 * j; const LAS float* s = scr + (8 * c) * 33 + n;
        u32x4 o; o.x = pk2(s[0 * 33], s[1 * 33]); o.y = pk2(s[2 * 33], s[3 * 33]); o.z = pk2(s[4 * 33], s[5 * 33]); o.w = pk2(s[6 * 33], s[7 * 33]);
        const int ng = n0 + n, row = mode == 0 ? ng : ((ng >> 2) * 8 + (ng & 3) + (mode == 2 ? 4 : 0));
        *(u32x4*)(WT + (size_t)row * ld + koff + k0 + 8 * c) = o; }
    asm volatile("s_waitcnt lgkmcnt(0)" ::: "memory");
}
__device__ __forceinline__ void phase0(const Args& a, LAS unsigned char* lds) {
    const int tid = threadIdx.x, lane = tid & 63, wave = tid >> 6, gw = blockIdx.x * 8 + wave, NGW = gridDim.x * 8;
    unsigned char* ws = a.ws;
    LAS float* scr = (LAS float*)(lds + wave * 16384);
    constexpr int I_IN = 16 * 120, I_OUT = 16 * 32, I_1 = 16 * 88, I_2 = 44 * 32, I_L = 16, I_G = 32;
    constexpr int NITEMS = I_IN + I_OUT + 2 * I_1 + I_2 + 2 * I_L + I_G;
    for (int it = gw; it < NITEMS; it += NGW) {
        int r = it;
        if (r < I_IN) { p0_transpose_item(a.in[2], 1024, 3840, (bf16*)(ws + WS_WTIN), 1024, 0, 0, scr, r, lane); continue; } r -= I_IN;
        if (r < I_OUT) { p0_transpose_item(a.in[16], 1024, 1024, (bf16*)(ws + WS_WTOUT), 1024, 0, 0, scr, r, lane); continue; } r -= I_OUT;
        if (r < I_1) { p0_transpose_item(a.in[18], 1024, 2816, (bf16*)(ws + WS_WT13), 1024, 0, 1, scr, r, lane); continue; } r -= I_1;
        if (r < I_1) { p0_transpose_item(a.in[19], 1024, 2816, (bf16*)(ws + WS_WT13), 1024, 0, 2, scr, r, lane); continue; } r -= I_1;
        if (r < I_2) { p0_transpose_item(a.in[20], 2816, 1024, (bf16*)(ws + WS_WT2), 2816, 0, 0, scr, r, lane); continue; } r -= I_2;
        if (r < I_L) { p0_transpose_item(a.in[7], 64, 512, (bf16*)(ws + WS_LT), 256, 0, 0, scr, r, lane); continue; } r -= I_L;
        if (r < I_L) { p0_transpose_item(a.in[9], 64, 512, (bf16*)(ws + WS_LT), 256, 64, 0, scr, r, lane); continue; } r -= I_L;
        p0_transpose_item(a.in[10], 128, 512, (bf16*)(ws + WS_LT), 256, 128, 0, scr, r, lane);
    }
    const float* x = a.in[0]; const float* nw = a.in[1]; bf16* XN = (bf16*)((unsigned char*)a.out + DO_XN);
    f32x4 wv[4];
#pragma unroll
    for (int j = 0; j < 4; ++j) wv[j] = *((const f32x4*)nw + 64 * j + lane);
    for (int m = gw; m < M; m += NGW) {
        const f32x4* xr = (const f32x4*)(x + (size_t)m * D) + lane;
        f32x4 v[4]; float s = 0.f;
#pragma unroll
        for (int j = 0; j < 4; ++j) { v[j] = xr[64 * j]; s += (v[j].x * v[j].x + v[j].y * v[j].y) + (v[j].z * v[j].z + v[j].w * v[j].w); }
        const float rstd = __builtin_amdgcn_rsqf(wave_sum(s) * (1.f / D) + 1e-6f);
        u32x2* o8 = (u32x2*)(XN + (size_t)m * D) + lane;
#pragma unroll
        for (int j = 0; j < 4; ++j) { u32x2 o; o.x = pk2(v[j].x * rstd * wv[j].x, v[j].y * rstd * wv[j].y); o.y = pk2(v[j].z * rstd * wv[j].z, v[j].w * rstd * wv[j].w); o8[64 * j] = o; }
    }
    const int gt = blockIdx.x * 512 + tid, NGT = gridDim.x * 512;
    if (gt < 512) { const float* hb = a.in[3]; ((float*)(ws + WS_LB))[gt] = 1.0f / (1.0f + __expf(hb[512 + gt] - hb[gt])); }
    for (int i = gt; i < 2 * M; i += NGT) ((float*)(ws + WS_SSQ1))[i] = 0.f;
}

constexpr int ALD = 264;
__device__ __forceinline__ void phase2(const Args& a, LAS unsigned char* lds) {
    const int tid = threadIdx.x, lane = tid & 63, wave = tid >> 6, tok = lane & 15, q = lane >> 4;
    unsigned char* ws = a.ws;
    const bf16* __restrict__ RW = (const bf16*)(ws + WS_RW); const bf16* __restrict__ LT = (const bf16*)(ws + WS_LT);
    const float* __restrict__ mix = a.in[5]; const float* __restrict__ w0 = a.in[6]; const float* __restrict__ a0 = a.in[8]; const float* __restrict__ k_k = a.in[11]; const float* __restrict__ k_a = a.in[12];
    float* __restrict__ Wd = (float*)(ws + WS_W); bf16* __restrict__ KK = (bf16*)(ws + WS_KK); bf16* __restrict__ BB = (bf16*)(ws + WS_BB); bf16* __restrict__ KM = (bf16*)(ws + WS_KM); bf16* __restrict__ R = (bf16*)(ws + WS_R); bf16* __restrict__ V = (bf16*)(ws + WS_V);
    bf16* __restrict__ G = (bf16*)((unsigned char*)a.out + DO_G);
    LAS bf16* A = (LAS bf16*)lds;
    for (int item = blockIdx.x; item < M / 64; item += gridDim.x) {
        const int row0 = item * 64;
        __syncthreads();
#pragma unroll
        for (int i = 0; i < 4; ++i) {
            const int vi = tid + 512 * i, t = vi >> 5, cg8 = vi & 31, row = row0 + t, col = 1536 + 8 * cg8;
            const u32x4 p = *(const u32x4*)(RW + (size_t)row * 1792 + col);
            u32x4 pp = (u32x4){0u, 0u, 0u, 0u};
            if ((row & (T - 1)) != 0) pp = *(const u32x4*)(RW + (size_t)(row - 1) * 1792 + col);
            const f32x4 m0 = *(const f32x4*)(mix + col), m1 = *(const f32x4*)(mix + col + 4);
            float f[8];
            f[0] = bflo(p.x) + (bflo(pp.x) - bflo(p.x)) * m0.x; f[1] = bfhi(p.x) + (bfhi(pp.x) - bfhi(p.x)) * m0.y;
            f[2] = bflo(p.y) + (bflo(pp.y) - bflo(p.y)) * m0.z; f[3] = bfhi(p.y) + (bfhi(pp.y) - bfhi(p.y)) * m0.w;
            f[4] = bflo(p.z) + (bflo(pp.z) - bflo(p.z)) * m1.x; f[5] = bfhi(p.z) + (bfhi(pp.z) - bfhi(p.z)) * m1.y;
            f[6] = bflo(p.w) + (bflo(pp.w) - bflo(p.w)) * m1.z; f[7] = bfhi(p.w) + (bfhi(pp.w) - bfhi(p.w)) * m1.w;
            if (cg8 < 8) {
#pragma unroll
                for (int j = 0; j < 8; ++j) f[j] = 1.0f - 2.0f * __builtin_amdgcn_rcpf(1.0f + __expf(2.0f * f[j]));
            } else if (cg8 >= 16) {
#pragma unroll
                for (int j = 0; j < 8; ++j) f[j] = sigmf(f[j]);
            }
            u32x4 o; o.x = pk2(f[0], f[1]); o.y = pk2(f[2], f[3]); o.z = pk2(f[4], f[5]); o.w = pk2(f[6], f[7]);
            *(LAS u32x4*)(A + t * ALD + 8 * cg8) = o;
        }
        __syncthreads();
        for (int mt = 0; mt < 4; ++mt) {
            f32x4 aw[4], aa[4], ag[4];
#pragma unroll
            for (int nt = 0; nt < 4; ++nt) { aw[nt] = (f32x4){0.f, 0.f, 0.f, 0.f}; aa[nt] = aw[nt]; ag[nt] = aw[nt]; }
            bf16x8 xf[8];
#pragma unroll
            for (int ks = 0; ks < 8; ++ks) xf[ks] = *(const LAS bf16x8*)(A + (16 * mt + tok) * ALD + 32 * ks + 8 * q);
#pragma unroll
            for (int nt = 0; nt < 4; ++nt) {
                const bf16* lrow = LT + (size_t)(64 * wave + 16 * (tok >> 2) + 4 * nt + (tok & 3)) * 256 + 8 * q;
#pragma unroll
                for (int ks = 0; ks < 8; ++ks) {
                    const bf16x8 wf = *(const bf16x8*)(lrow + 32 * ks);
                    if (ks < 2) aw[nt] = __builtin_amdgcn_mfma_f32_16x16x32_bf16(wf, xf[ks], aw[nt], 0, 0, 0);
                    else if (ks < 4) aa[nt] = __builtin_amdgcn_mfma_f32_16x16x32_bf16(wf, xf[ks], aa[nt], 0, 0, 0);
                    else ag[nt] = __builtin_amdgcn_mfma_f32_16x16x32_bf16(wf, xf[ks], ag[nt], 0, 0, 0);
                }
            }
            const int row = row0 + 16 * mt + tok; const bool hasprev = (row & (T - 1)) != 0;
            const bf16* pr = RW + (size_t)row * 1792; const bf16* ppr = pr - 1792;
            float kkv[4][4], av[4][4]; float ss = 0.f;
#pragma unroll
            for (int nt = 0; nt < 4; ++nt) {
                const int c = 64 * wave + 16 * q + 4 * nt;
                float rr[4], kk[4], vv[4];
#pragma unroll
                for (int part = 0; part < 3; ++part) {
                    const u32x2 p = *(const u32x2*)(pr + 512 * part + c); u32x2 pp = (u32x2){0u, 0u};
                    if (hasprev) pp = *(const u32x2*)(ppr + 512 * part + c);
                    const f32x4 mx = *(const f32x4*)(mix + 512 * part + c);
                    float* dst = part == 0 ? rr : (part == 1 ? kk : vv);
                    dst[0] = bflo(p.x) + (bflo(pp.x) - bflo(p.x)) * mx.x; dst[1] = bfhi(p.x) + (bfhi(pp.x) - bfhi(p.x)) * mx.y;
                    dst[2] = bflo(p.y) + (bflo(pp.y) - bflo(p.y)) * mx.z; dst[3] = bfhi(p.y) + (bfhi(pp.y) - bfhi(p.y)) * mx.w;
                }
                const f32x4 w0v = *(const f32x4*)(w0 + c), a0v = *(const f32x4*)(a0 + c), kkw = *(const f32x4*)(k_k + c), kaw = *(const f32x4*)(k_a + c);
                f32x4 dec; float km[4];
#pragma unroll
                for (int j = 0; j < 4; ++j) {
                    const float z = -(w0v[j] + aw[nt][j]);
                    const float sp = fmaxf(z, 0.f) + __logf(1.0f + __expf(-fabsf(z)));
                    dec[j] = __expf(-__expf(-sp - 0.5f));
                    const float al = sigmf(a0v[j] + aa[nt][j]);
                    av[nt][j] = al;
                    kkv[nt][j] = kk[j] * kkw[j]; ss += kkv[nt][j] * kkv[nt][j];
                    km[j] = kk[j] * (1.0f + (al - 1.0f) * kaw[j]);
                }
                const size_t o = (size_t)row * 512 + c;
                *(f32x4*)(Wd + o) = dec;
                u32x2 t2; t2.x = pk2(rr[0], rr[1]); t2.y = pk2(rr[2], rr[3]); *(u32x2*)(R + o) = t2;
                t2.x = pk2(km[0], km[1]); t2.y = pk2(km[2], km[3]); *(u32x2*)(KM + o) = t2;
                t2.x = pk2(vv[0], vv[1]); t2.y = pk2(vv[2], vv[3]); *(u32x2*)(V + o) = t2;
                t2.x = pk2(ag[nt][0], ag[nt][1]); t2.y = pk2(ag[nt][2], ag[nt][3]); *(u32x2*)(G + o) = t2;
            }
            ss += __shfl_xor(ss, 16); ss += __shfl_xor(ss, 32);
            const float inv = 1.0f / fmaxf(sqrtf(ss), 1e-12f);
#pragma unroll
            for (int nt = 0; nt < 4; ++nt) {
                const size_t o = (size_t)row * 512 + 64 * wave + 16 * q + 4 * nt;
                float kn[4];
#pragma unroll
                for (int j = 0; j < 4; ++j) kn[j] = kkv[nt][j] * inv;
                u32x2 t2; t2.x = pk2(kn[0], kn[1]); t2.y = pk2(kn[2], kn[3]); *(u32x2*)(KK + o) = t2;
                t2.x = pk2(-kn[0] * av[nt][0], -kn[1] * av[nt][1]); t2.y = pk2(-kn[2] * av[nt][2], -kn[3] * av[nt][3]); *(u32x2*)(BB + o) = t2;
            }
        }
    }
}
__device__ __forceinline__ void rwkv_scan(const Args& a, LAS unsigned char* lds, int bh, int sl) {
    const int tid = threadIdx.x; unsigned char* ws = a.ws;
    const int b = bh >> 3, h = bh & 7; const size_t m0 = (size_t)b * T; const int c0 = 64 * h;
    const float* Wd = (const float*)(ws + WS_W); const bf16* KK = (const bf16*)(ws + WS_KK); const bf16* BB = (const bf16*)(ws + WS_BB);
    const bf16* KM = (const bf16*)(ws + WS_KM); const bf16* R = (const bf16*)(ws + WS_R); const bf16* V = (const bf16*)(ws + WS_V);
    float* Y = (float*)(ws + WS_Y);
    constexpr int BUF = 5 * 16 * 64 * 4 + 16 * 16 * 4;
    constexpr int NT = T / 16;
    if (tid >= 256) {
        const int lt = tid - 256, st = lt >> 4, l16 = lt & 15, c4 = 4 * l16;
        f32x4 w; u32x2 kk, bb, km, r; bf16 v;
#define RW_LOAD(tile) do { const size_t row = m0 + (size_t)(tile) * 16 + st; const size_t o = row * 512 + c0 + c4; \
        w = *(const f32x4*)(Wd + o); kk = *(const u32x2*)(KK + o); bb = *(const u32x2*)(BB + o); km = *(const u32x2*)(KM + o); r = *(const u32x2*)(R + o); v = V[row * 512 + c0 + 16 * sl + l16]; } while (0)
#define RW_STORE(bufi) do { LAS float* B = (LAS float*)(lds + (bufi) * BUF); const int o = st * 64 + c4; \
        *(LAS f32x4*)(B + o) = w; \
        *(LAS f32x4*)(B + 1024 + o) = (f32x4){bflo(kk.x), bfhi(kk.x), bflo(kk.y), bfhi(kk.y)}; \
        *(LAS f32x4*)(B + 2048 + o) = (f32x4){bflo(bb.x), bfhi(bb.x), bflo(bb.y), bfhi(bb.y)}; \
        *(LAS f32x4*)(B + 3072 + o) = (f32x4){bflo(km.x), bfhi(km.x), bflo(km.y), bfhi(km.y)}; \
        *(LAS f32x4*)(B + 4096 + o) = (f32x4){bflo(r.x), bfhi(r.x), bflo(r.y), bfhi(r.y)}; \
        B[5120 + st * 16 + l16] = bf1(v); } while (0)
        RW_LOAD(0); RW_STORE(0); RW_LOAD(1);
        __syncthreads();
        for (int it = 0; it < NT; ++it) {
            if (it + 1 < NT) RW_STORE((it + 1) & 1);
            if (it + 2 < NT) RW_LOAD(it + 2);
            __syncthreads();
        }
#undef RW_LOAD
#undef RW_STORE
    } else {
        const int wv = tid >> 6, l = tid & 63, rloc = 4 * wv + (l >> 4), kq = l & 15;
        f32x2 S01 = (f32x2){0.f, 0.f}, S23 = S01;
        float* yrow = Y + ((size_t)bh * 64 + 16 * sl + rloc) * T + kq;
        __syncthreads();
        for (int it = 0; it < NT; ++it) {
            const LAS float* B = (const LAS float*)(lds + (it & 1) * BUF);
            float ysel = 0.f;
#pragma unroll 4
            for (int st = 0; st < 16; ++st) {
                const int o = st * 64 + 4 * kq;
                const f32x4 w = *(const LAS f32x4*)(B + o), kk = *(const LAS f32x4*)(B + 1024 + o), bn = *(const LAS f32x4*)(B + 2048 + o), km = *(const LAS f32x4*)(B + 3072 + o), r = *(const LAS f32x4*)(B + 4096 + o);
                const float vv = B[5120 + st * 16 + rloc];
                const f32x2 p2 = S01 * kk.lo + S23 * kk.hi;
                const float sa = rowsum16(p2.x + p2.y);
                const f32x2 sa2 = (f32x2){sa, sa}, vv2 = (f32x2){vv, vv};
                S01 = S01 * w.lo + (sa2 * bn.lo + vv2 * km.lo);
                S23 = S23 * w.hi + (sa2 * bn.hi + vv2 * km.hi);
                const f32x2 y2 = S01 * r.lo + S23 * r.hi;
                const float y = rowsum16(y2.x + y2.y);
                ysel = (kq == st) ? y : ysel;
            }
            yrow[it * 16] = ysel;
            __syncthreads();
        }
    }
}
__device__ __forceinline__ void hgrn_scan(const Args& a, LAS unsigned char* lds, int bh, int sl) {
    const int tid = threadIdx.x; unsigned char* ws = a.ws;
    const int b = bh >> 2, h = bh & 3; const size_t m0 = (size_t)b * T;
    const bf16* HG = (const bf16*)(ws + WS_HG);
    float* OH = (float*)((unsigned char*)a.out + DO_OH);
    constexpr int BUF = 2 * 16 * 128 * 4 + 16 * 16 * 4;
    constexpr int NT = T / 16;
    if (tid >= 256) {
        const int lt = tid - 256, st = lt >> 4, l16 = lt & 15, c8 = 8 * l16;
        u32x4 f, q; bf16 iv;
#define HG_LOAD(tile) do { const bf16* rp = HG + (m0 + (size_t)(tile) * 16 + st) * 2048 + 128 * h; \
        q = *(const u32x4*)(rp + c8); f = *(const u32x4*)(rp + 512 + c8); iv = rp[1024 + 16 * sl + l16]; } while (0)
#define HG_STORE(bufi) do { LAS float* B = (LAS float*)(lds + (bufi) * BUF); const int o = st * 128 + c8; \
        *(LAS f32x4*)(B + o) = (f32x4){bflo(f.x), bfhi(f.x), bflo(f.y), bfhi(f.y)}; *(LAS f32x4*)(B + o + 4) = (f32x4){bflo(f.z), bfhi(f.z), bflo(f.w), bfhi(f.w)}; \
        *(LAS f32x4*)(B + 2048 + o) = (f32x4){bflo(q.x), bfhi(q.x), bflo(q.y), bfhi(q.y)}; *(LAS f32x4*)(B + 2048 + o + 4) = (f32x4){bflo(q.z), bfhi(q.z), bflo(q.w), bfhi(q.w)}; \
        B[4096 + st * 16 + l16] = bf1(iv); } while (0)
        HG_LOAD(0); HG_STORE(0); HG_LOAD(1);
        __syncthreads();
        for (int it = 0; it < NT; ++it) {
            if (it + 1 < NT) HG_STORE((it + 1) & 1);
            if (it + 2 < NT) HG_LOAD(it + 2);
            __syncthreads();
        }
#undef HG_LOAD
#undef HG_STORE
    } else {
        const int wv = tid >> 6, l = tid & 63, rloc = 4 * wv + (l >> 4), kq = l & 15;
        f32x2 S0 = (f32x2){0.f, 0.f}, S1 = S0, S2 = S0, S3 = S0;
        float* orow = OH + ((size_t)bh * 128 + 16 * sl + rloc) * T + kq;
        __syncthreads();
        for (int it = 0; it < NT; ++it) {
            const LAS float* B = (const LAS float*)(lds + (it & 1) * BUF);
            float osel = 0.f;
#pragma unroll 4
            for (int st = 0; st < 16; ++st) {
                const int o = st * 128 + 4 * kq;
                const f32x4 f0 = *(const LAS f32x4*)(B + o), f1 = *(const LAS f32x4*)(B + o + 64), q0 = *(const LAS f32x4*)(B + 2048 + o), q1 = *(const LAS f32x4*)(B + 2048 + o + 64);
                const float iv = B[4096 + st * 16 + rloc];
                const f32x2 iv2 = (f32x2){iv, iv};
                S0 = f0.lo * (S0 - iv2) + iv2; S1 = f0.hi * (S1 - iv2) + iv2; S2 = f1.lo * (S2 - iv2) + iv2; S3 = f1.hi * (S3 - iv2) + iv2;
                const f32x2 p2 = (S0 * q0.lo + S1 * q0.hi) + (S2 * q1.lo + S3 * q1.hi);
                const float p = rowsum16(p2.x + p2.y);
                osel = (kq == st) ? p : osel;
            }
            orow[it * 16] = osel;
            __syncthreads();
        }
    }
}
__device__ __forceinline__ void phase3(const Args& a, LAS unsigned char* lds) {
    for (int item = blockIdx.x; item < 256; item += gridDim.x) {
        const int x = item & 7, j = item >> 3;
        __syncthreads();
        if (j < 16) rwkv_scan(a, lds, x * 4 + (j >> 2), j & 3);
        else hgrn_scan(a, lds, x * 2 + ((j - 16) >> 3), (j - 16) & 7);
    }
}

__device__ __forceinline__ float red8(float v) { v = dpp_add<0xB1>(v); v = dpp_add<0x4E>(v); v = dpp_add<0x141>(v); return v; }
__device__ __forceinline__ void phase4(const Args& a, LAS unsigned char* lds) {
    const int tid = threadIdx.x, lane = tid & 63, wave = tid >> 6, gw = blockIdx.x * 8 + wave, NGW = gridDim.x * 8, tk = lane >> 3, cg = lane & 7;
    unsigned char* ws = a.ws;
    bf16* __restrict__ MIX = (bf16*)(ws + WS_MIX);
    const float* __restrict__ Y = (const float*)(ws + WS_Y); const float* __restrict__ OH = (const float*)((unsigned char*)a.out + DO_OH);
    const bf16* __restrict__ R = (const bf16*)(ws + WS_R); const bf16* __restrict__ KM = (const bf16*)(ws + WS_KM); const bf16* __restrict__ V = (const bf16*)(ws + WS_V); const bf16* __restrict__ G = (const bf16*)((unsigned char*)a.out + DO_G);
    const bf16* __restrict__ HG = (const bf16*)(ws + WS_HG);
    const float* __restrict__ r_k = a.in[13]; const float* __restrict__ ln_w = a.in[14]; const float* __restrict__ ln_b = a.in[15]; const float* __restrict__ hnw = a.in[4];
    LAS float* Yt = (LAS float*)(lds + wave * 17408);
    constexpr int N_RW = 32 * 128, N_HG = 16 * 128;
    for (int it = gw; it < N_RW + N_HG; it += NGW) {
        if (it < N_RW) {
            const int bh = it >> 7, tile = it & 127, b = bh >> 3, h = bh & 7, t0 = tile * 64;
            const float* yp = Y + (size_t)bh * 64 * T + t0 + lane;
#pragma unroll 16
            for (int v = 0; v < 64; ++v) Yt[v * 65 + lane] = yp[(size_t)v * T];
            asm volatile("s_waitcnt lgkmcnt(0)" ::: "memory");
            const int c = 64 * h + 8 * cg;
            const f32x4 k0 = *(const f32x4*)(r_k + c), k1 = *(const f32x4*)(r_k + c + 4), w0 = *(const f32x4*)(ln_w + c), w1 = *(const f32x4*)(ln_w + c + 4), b0 = *(const f32x4*)(ln_b + c), b1 = *(const f32x4*)(ln_b + c + 4);
            const float kr[8] = {k0.x, k0.y, k0.z, k0.w, k1.x, k1.y, k1.z, k1.w}, lw[8] = {w0.x, w0.y, w0.z, w0.w, w1.x, w1.y, w1.z, w1.w}, lb[8] = {b0.x, b0.y, b0.z, b0.w, b1.x, b1.y, b1.z, b1.w};
#pragma unroll 2
            for (int i = 0; i < 8; ++i) {
                const int tok = 8 * i + tk; const size_t row = (size_t)b * T + t0 + tok, o = row * 512 + c;
                const u32x4 rr = *(const u32x4*)(R + o), kk = *(const u32x4*)(KM + o), vv = *(const u32x4*)(V + o), gg = *(const u32x4*)(G + o);
                float y[8]; float s = 0.f;
#pragma unroll
                for (int j = 0; j < 8; ++j) { y[j] = Yt[(8 * cg + j) * 65 + tok]; s += y[j]; }
                const float mu = red8(s) * (1.f / 64.f); float q = 0.f;
#pragma unroll
                for (int j = 0; j < 8; ++j) { y[j] -= mu; q += y[j] * y[j]; }
                const float rs = __builtin_amdgcn_rsqf(red8(q) * (1.f / 64.f) + 64e-5f);
                const float rv[8] = {bflo(rr.x), bfhi(rr.x), bflo(rr.y), bfhi(rr.y), bflo(rr.z), bfhi(rr.z), bflo(rr.w), bfhi(rr.w)};
                const float kv[8] = {bflo(kk.x), bfhi(kk.x), bflo(kk.y), bfhi(kk.y), bflo(kk.z), bfhi(kk.z), bflo(kk.w), bfhi(kk.w)};
                const float vf[8] = {bflo(vv.x), bfhi(vv.x), bflo(vv.y), bfhi(vv.y), bflo(vv.z), bfhi(vv.z), bflo(vv.w), bfhi(vv.w)};
                const float gf[8] = {bflo(gg.x), bfhi(gg.x), bflo(gg.y), bfhi(gg.y), bflo(gg.z), bfhi(gg.z), bflo(gg.w), bfhi(gg.w)};
                float dot = 0.f;
#pragma unroll
                for (int j = 0; j < 8; ++j) dot += rv[j] * kv[j] * kr[j];
                dot = red8(dot);
                float e[8];
#pragma unroll
                for (int j = 0; j < 8; ++j) e[j] = (y[j] * rs * lw[j] + lb[j] + dot * vf[j]) * gf[j];
                u32x4 ov; ov.x = pk2(e[0], e[1]); ov.y = pk2(e[2], e[3]); ov.z = pk2(e[4], e[5]); ov.w = pk2(e[6], e[7]);
                *(u32x4*)(MIX + row * 1024 + 512 + c) = ov;
            }
            asm volatile("s_waitcnt lgkmcnt(0)" ::: "memory");
        } else {
            const int i2 = it - N_RW, bh = i2 >> 7, tile = i2 & 127, b = bh >> 2, h = bh & 3, t0 = tile * 64;
            const float* op = OH + (size_t)bh * 128 * T + t0 + lane;
            float ss = 0.f;
#pragma unroll 16
            for (int v = 0; v < 128; ++v) { const float o = op[(size_t)v * T]; ss += o * o; }
            Yt[64 * 65 + lane] = __builtin_amdgcn_rsqf(ss * (1.f / 128.f) + 1e-6f);
            for (int half = 0; half < 2; ++half) {
#pragma unroll 16
                for (int v = 0; v < 64; ++v) Yt[v * 65 + lane] = op[(size_t)(64 * half + v) * T];
                asm volatile("s_waitcnt lgkmcnt(0)" ::: "memory");
                const int c = 128 * h + 64 * half + 8 * cg;
                const f32x4 w0 = *(const f32x4*)(hnw + c), w1 = *(const f32x4*)(hnw + c + 4);
                const float wv[8] = {w0.x, w0.y, w0.z, w0.w, w1.x, w1.y, w1.z, w1.w};
#pragma unroll 2
                for (int i = 0; i < 8; ++i) {
                    const int tok = 8 * i + tk; const size_t row = (size_t)b * T + t0 + tok;
                    const u32x4 gg = *(const u32x4*)(HG + row * 2048 + 1536 + c);
                    const float rs = Yt[64 * 65 + tok];
                    const float gf[8] = {bflo(gg.x), bfhi(gg.x), bflo(gg.y), bfhi(gg.y), bflo(gg.z), bfhi(gg.z), bflo(gg.w), bfhi(gg.w)};
                    float e[8];
#pragma unroll
                    for (int j = 0; j < 8; ++j) e[j] = Yt[(8 * cg + j) * 65 + tok] * rs * wv[j] * gf[j] * sigmf(gf[j]);
                    u32x4 ov; ov.x = pk2(e[0], e[1]); ov.y = pk2(e[2], e[3]); ov.z = pk2(e[4], e[5]); ov.w = pk2(e[6], e[7]);
                    *(u32x4*)(MIX + row * 1024 + c) = ov;
                }
                asm volatile("s_waitcnt lgkmcnt(0)" ::: "memory");
            }
        }
    }
}

__device__ __forceinline__ void phase8(const Args& a) {
    const int tid = threadIdx.x, lane = tid & 63, wave = tid >> 6, gw = blockIdx.x * 8 + wave, NGW = gridDim.x * 8;
    const float* fw = a.in[21]; const float* ssq = (const float*)(a.ws + WS_SSQ2);
    f32x4 wv[4];
#pragma unroll
    for (int j = 0; j < 4; ++j) wv[j] = *((const f32x4*)fw + 64 * j + lane);
    for (int m = gw; m < M; m += NGW) {
        const float rstd = __builtin_amdgcn_rsqf(ssq[m] * (1.f / D) + 1e-6f);
        f32x4* xr = (f32x4*)(a.out + (size_t)m * D) + lane;
#pragma unroll
        for (int j = 0; j < 4; ++j) { f32x4 v = xr[64 * j]; v = v * rstd * wv[j]; xr[64 * j] = v; }
    }
}

__global__ void __launch_bounds__(512, 2) fwd_kernel(Args a) {
    extern __shared__ __attribute__((aligned(16))) unsigned char lds_raw[];
    LAS unsigned char* lds = (LAS unsigned char*)lds_raw;
    cg::grid_group grid = cg::this_grid();
    unsigned char* ws = a.ws;
    volatile LAS unsigned* bst = (volatile LAS unsigned*)(lds + LDS_BYTES - 16);
    if (threadIdx.x < 4) bst[threadIdx.x] = 0u;
    __syncthreads();
    XcdBarrier xbar = xcd_barrier_post((unsigned*)(ws + WS_BAR), bst);
    const int lo = a.ph_lo, hi = a.ph_hi;
#define IN(k) (lo <= (k) && (k) < hi)
#define SEAM(k) do { if ((k) + 1 < hi) { if ((k) == 0) grid.sync(); else xcd_barrier(xbar); } } while (0)
    {
        if (IN(0)) { phase0(a, lds); SEAM(0); }
        if (IN(1)) {
            pg8::Gemm g{(const pg8::bf16_t*)((unsigned char*)a.out + DO_XN), (const pg8::bf16_t*)(ws + WS_WTIN), M, 3840, 1024}; pg8::StaticOrder S; S.init(M, 3840, gridDim.x, blockIdx.x);
            pg8::EpiProj E{(pg8::bf16_t*)(ws + WS_HG), (pg8::bf16_t*)(ws + WS_RW), (const float*)(ws + WS_LB)};
            pg8::gemm_phase<pg8::EpiProj, pg8::StaticOrder>((PG8_LAS unsigned char*)lds, g, S, E, nullptr); SEAM(1);
        }
        if (IN(2)) { phase2(a, lds); SEAM(2); }
        if (IN(3)) { phase3(a, lds); SEAM(3); }
        if (IN(4)) { phase4(a, lds); SEAM(4); }
        if (IN(5)) {
            pg8::Gemm g{(const pg8::bf16_t*)(ws + WS_MIX), (const pg8::bf16_t*)(ws + WS_WTOUT), M, 1024, 1024}; pg8::StaticOrder S; S.init(M, 1024, gridDim.x, blockIdx.x);
            pg8::EpiRes<true> E{a.in[0], a.out, (pg8::bf16_t*)(ws + WS_X1B), a.in[17], (float*)(ws + WS_SSQ1)};
            pg8::gemm_phase<pg8::EpiRes<true>, pg8::StaticOrder>((PG8_LAS unsigned char*)lds, g, S, E, nullptr); SEAM(5);
        }
        if (IN(6)) {
            pg8::Gemm g{(const pg8::bf16_t*)(ws + WS_X1B), (const pg8::bf16_t*)(ws + WS_WT13), M, 2 * FF, 1024}; pg8::StaticOrder S; S.init(M, 2 * FF, gridDim.x, blockIdx.x);
            pg8::EpiGlu E{(pg8::bf16_t*)(ws + WS_U), (const float*)(ws + WS_SSQ1)};
            pg8::gemm_phase<pg8::EpiGlu, pg8::StaticOrder>((PG8_LAS unsigned char*)lds, g, S, E, nullptr); SEAM(6);
        }
        if (IN(7)) {
            pg8::Gemm g{(const pg8::bf16_t*)(ws + WS_U), (const pg8::bf16_t*)(ws + WS_WT2), M, 1024, FF}; pg8::StaticOrder S; S.init(M, 1024, gridDim.x, blockIdx.x);
            pg8::EpiRes<false> E{a.out, a.out, nullptr, nullptr, (float*)(ws + WS_SSQ2)};
            pg8::gemm_phase<pg8::EpiRes<false>, pg8::StaticOrder>((PG8_LAS unsigned char*)lds, g, S, E, nullptr); SEAM(7);
        }
        if (IN(8)) phase8(a);
    }
#undef IN
#undef SEAM
}

extern "C" void kernel_launch(void* const* d_in, const int* in_sizes, int n_in, void* d_out, int out_size, void* d_ws, size_t ws_size, hipStream_t stream) {
    static int grid = 0;
    if (grid == 0) {
        if (n_in != 22 || out_size != M * D || ws_size < WS_END) { fprintf(stderr, "kernel_launch: unexpected problem (n_in %d, out %d, ws %zu)\n", n_in, out_size, ws_size); grid = -1; return; }
        int dev = 0, cus = 0, per_cu = 0;
        if (hipGetDevice(&dev) != hipSuccess || hipDeviceGetAttribute(&cus, hipDeviceAttributeMultiprocessorCount, dev) != hipSuccess) { grid = -1; return; }
        if (hipFuncSetAttribute((const void*)fwd_kernel, hipFuncAttributeMaxDynamicSharedMemorySize, LDS_BYTES) != hipSuccess) { fprintf(stderr, "kernel_launch: hipFuncSetAttribute failed\n"); grid = -1; return; }
        if (hipOccupancyMaxActiveBlocksPerMultiprocessor(&per_cu, (const void*)fwd_kernel, 512, LDS_BYTES) != hipSuccess || per_cu < 1) { fprintf(stderr, "kernel_launch: occupancy query says %d\n", per_cu); per_cu = 1; }
        (void)hipGetLastError();
        grid = cus * 1;
    }
    if (grid < 0) return;
    if (hipMemsetAsync((char*)d_ws + WS_BAR, 0, 16384, stream) != hipSuccess) { fprintf(stderr, "kernel_launch: memset failed\n"); return; }
    Args a{};
    for (int i = 0; i < 22; ++i) a.in[i] = (const float*)d_in[i];
    a.out = (float*)d_out; a.ws = (unsigned char*)d_ws;
    if (N_LAUNCHES == 1) {
        a.ph_lo = 0; a.ph_hi = NPHASE;
        void* args[] = {&a};
        hipError_t e = hipLaunchCooperativeKernel((const void*)fwd_kernel, dim3(grid), dim3(512), args, LDS_BYTES, stream);
        if (e != hipSuccess) fprintf(stderr, "cooperative launch failed: %s (grid %d)\n", hipGetErrorString(e), grid);
    } else {
        for (int ph = 0; ph < NPHASE; ++ph) { a.ph_lo = ph; a.ph_hi = ph + 1; hipLaunchKernelGGL(fwd_kernel, dim3(grid), dim3(512), LDS_BYTES, stream, a);
#ifdef PROBE_DUP
            if (ph == PROBE_DUP) hipLaunchKernelGGL(fwd_kernel, dim3(grid), dim3(512), LDS_BYTES, stream, a);
#endif
        }
    }
}
```

```cpp
#include <hip/hip_runtime.h>
#include <hip/hip_cooperative_groups.h>
#include <cstdio>
namespace cg = cooperative_groups;
namespace pg8 {
#define PG8_LAS __attribute__((address_space(3)))
typedef unsigned short bf16_t;
typedef short bf16x8 __attribute__((ext_vector_type(8)));
typedef float f32x4 __attribute__((ext_vector_type(4)));
typedef unsigned u32x4 __attribute__((ext_vector_type(4)));
constexpr int BM = 256, BK = 64, HALF = 128, HTB = HALF * BK * 2  , STAGE_BYTES = 8 * HTB, NXCD = 8, WGM = 8;

__host__ __device__ __forceinline__ int lds_byte(int r, int c) { const int st = (r >> 4) * 2 + (c >> 5), rr = r & 15, cc = c & 31, ob = rr * 64 + cc * 2; return st * 1024 + (ob ^ (((ob >> 9) & 1) << 5)); }
__host__ __device__ __forceinline__ void stage_rc(int b, int& R, int& C) { const int st = b / 1024, sb = b % 1024, swz = sb ^ (((sb >> 9) & 1) << 5); R = (st >> 1) * 16 + swz / 64; C = (st & 1) * 32 + (swz % 64) / 2; }
__host__ __device__ __forceinline__ int perm32(int rho) { const int n = rho >> 4, i = rho & 15; return 8 * (i >> 2) + 4 * n + (i & 3); }

struct Unit { int pm, pn; };
struct Gemm { const bf16_t* A; const bf16_t* Bt; int M, N, K; };

struct StaticOrder {
    int nM, nN, nwg, G, c;
    __host__ __device__ void init(int M, int N, int G_, int c_) { nM = M / BM; nN = N / BM; nwg = nM * nN; G = G_; c = c_; }
    __host__ __device__ bool next(int i, Unit& u) const {
        const long L = (long)i * G + c; if (L >= nwg) return false;
        int wgid = (int)L; { const int q = nwg / NXCD, r = nwg % NXCD, xcd = wgid % NXCD, off = wgid / NXCD; wgid = (xcd < r ? xcd * (q + 1) : r * (q + 1) + (xcd - r) * q) + off; }
        const int nig = WGM * nN, gid = wgid / nig, fm = gid * WGM, gsz = (nM - fm) < WGM ? (nM - fm) : WGM;
        u.pm = fm + ((wgid % nig) % gsz); u.pn = (wgid % nig) / gsz; return true;
    }
    __device__ __forceinline__ void a_ready(const Unit&) const {}
    __device__ __forceinline__ void done(const Unit&) const {}
};
__device__ __forceinline__ unsigned cvt_pk_bf16(float lo, float hi) { unsigned r; asm volatile("v_cvt_pk_bf16_f32 %0, %1, %2" : "=v"(r) : "v"(lo), "v"(hi)); return r; }
__device__ __forceinline__ float sigm(float v) { return __builtin_amdgcn_rcpf(1.0f + __expf(-v)); }
struct EpiProj {
    static constexpr bool PERM = true, AFTER_DRAIN = false;
    bf16_t* HG; bf16_t* RW; const float* LB;
    __device__ __forceinline__ void operator()(const f32x4 (&acc)[2][2][4][2], const Unit& u, int wr, int wc, int fr, int fq) const {
        const int row0 = u.pm * BM + wr * 64 + fr, cb = u.pn * BM + wc * 32 + 8 * fq;
        const int mode = u.pn < 2 ? 0 : (u.pn < 4 ? 1 : 2);
#pragma unroll
        for (int bj = 0; bj < 2; ++bj) {
            const int col = cb + bj * HALF;
            f32x4 l0 = (f32x4){0.f, 0.f, 0.f, 0.f}, l1 = l0;
            if (mode == 1) { l0 = *(const f32x4*)(LB + col - 512); l1 = *(const f32x4*)(LB + col - 512 + 4); }
#pragma unroll
            for (int ai = 0; ai < 2; ++ai)
#pragma unroll
                for (int m = 0; m < 4; ++m) {
                    const int row = row0 + ai * HALF + m * 16;
                    f32x4 v0 = acc[ai][bj][m][0], v1 = acc[ai][bj][m][1];
                    if (mode == 0) {
#pragma unroll
                        for (int j = 0; j < 4; ++j) { v0[j] = v0[j] * sigm(v0[j]); v1[j] = v1[j] * sigm(v1[j]); }
                    } else if (mode == 1) {
#pragma unroll
                        for (int j = 0; j < 4; ++j) { v0[j] = l0[j] + (1.0f - l0[j]) * sigm(v0[j]); v1[j] = l1[j] + (1.0f - l1[j]) * sigm(v1[j]); }
                    }
                    u32x4 w; w.x = cvt_pk_bf16(v0[0], v0[1]); w.y = cvt_pk_bf16(v0[2], v0[3]); w.z = cvt_pk_bf16(v1[0], v1[1]); w.w = cvt_pk_bf16(v1[2], v1[3]);
                    bf16_t* dst = (u.pn < 8) ? HG + (size_t)row * 2048 + col : RW + (size_t)row * 1792 + (col - 2048);
                    *(u32x4*)dst = w;
                }
        }
    }
};
template <bool WB> struct EpiRes {
    static constexpr bool PERM = true, AFTER_DRAIN = false;
    const float* X; float* X1; bf16_t* X1B; const float* NW; float* SSQ;
    __device__ __forceinline__ void operator()(const f32x4 (&acc)[2][2][4][2], const Unit& u, int wr, int wc, int fr, int fq) const {
        const int row0 = u.pm * BM + wr * 64 + fr, cb = u.pn * BM + wc * 32 + 8 * fq;
#pragma unroll
        for (int ai = 0; ai < 2; ++ai)
#pragma unroll
            for (int m = 0; m < 4; ++m) {
                const int row = row0 + ai * HALF + m * 16; float ss = 0.f;
#pragma unroll
                for (int bj = 0; bj < 2; ++bj) {
                    const size_t off = (size_t)row * 1024 + cb + bj * HALF;
                    f32x4 v0 = acc[ai][bj][m][0] + *(const f32x4*)(X + off), v1 = acc[ai][bj][m][1] + *(const f32x4*)(X + off + 4);
                    *(f32x4*)(X1 + off) = v0; *(f32x4*)(X1 + off + 4) = v1;
                    ss += (v0[0] * v0[0] + v0[1] * v0[1]) + (v0[2] * v0[2] + v0[3] * v0[3]) + (v1[0] * v1[0] + v1[1] * v1[1]) + (v1[2] * v1[2] + v1[3] * v1[3]);
                    if (WB) { const f32x4 n0 = *(const f32x4*)(NW + cb + bj * HALF), n1 = *(const f32x4*)(NW + cb + bj * HALF + 4);
                        u32x4 w; w.x = cvt_pk_bf16(v0[0] * n0[0], v0[1] * n0[1]); w.y = cvt_pk_bf16(v0[2] * n0[2], v0[3] * n0[3]); w.z = cvt_pk_bf16(v1[0] * n1[0], v1[1] * n1[1]); w.w = cvt_pk_bf16(v1[2] * n1[2], v1[3] * n1[3]);
                        *(u32x4*)(X1B + off) = w; }
                }
                ss += __shfl_xor(ss, 16); ss += __shfl_xor(ss, 32);
                if (fq == 0) unsafeAtomicAdd(SSQ + row, ss);
            }
    }
};
struct EpiGlu {
    static constexpr bool PERM = true, AFTER_DRAIN = false;
    bf16_t* U; const float* SSQ;
    __device__ __forceinline__ void operator()(const f32x4 (&acc)[2][2][4][2], const Unit& u, int wr, int wc, int fr, int fq) const {
        const int row0 = u.pm * BM + wr * 64 + fr, cb = (u.pn * BM + wc * 32 + 8 * fq) >> 1;
#pragma unroll
        for (int ai = 0; ai < 2; ++ai)
#pragma unroll
            for (int m = 0; m < 4; ++m) {
                const int row = row0 + ai * HALF + m * 16;
                const float rstd = __builtin_amdgcn_rsqf(SSQ[row] * (1.0f / 1024.0f) + 1e-6f);
#pragma unroll
                for (int bj = 0; bj < 2; ++bj) {
                    const f32x4 g = acc[ai][bj][m][0] * rstd, up = acc[ai][bj][m][1] * rstd; float h[4];
#pragma unroll
                    for (int j = 0; j < 4; ++j) h[j] = g[j] * sigm(g[j]) * up[j];
                    typedef unsigned u32x2 __attribute__((ext_vector_type(2)));
                    u32x2 w; w.x = cvt_pk_bf16(h[0], h[1]); w.y = cvt_pk_bf16(h[2], h[3]);
                    *(u32x2*)(U + (size_t)row * 2816 + cb + bj * (HALF / 2)) = w;
                }
            }
    }
};

template <class Epi, class Sched, bool STAMP = false>
__device__ __forceinline__ void gemm_phase(PG8_LAS unsigned char* lds, const Gemm g, const Sched& S, const Epi& E, unsigned long long* stamps) {
    const int tid = threadIdx.x, wid = __builtin_amdgcn_readfirstlane(tid >> 6), lane = tid & 63, wr = wid >> 2, wc = wid & 3, fr = lane & 15, fq = lane >> 4;
    const int K = g.K, nt = K / BK;
    int ts_lo = 0, ts_hi = 0, nts = 0; const unsigned long long rt_entry = STAMP ? (unsigned long long)wall_clock64() : 0ull;
#define PG8_STAMP() do { if (STAMP && wid == 0 && nts < 64) { const unsigned long long _c = (unsigned long long)clock64(); \
        ts_lo = (lane == nts) ? (int)(unsigned)_c : ts_lo; ts_hi = (lane == nts) ? (int)(unsigned)(_c >> 32) : ts_hi; ++nts; } } while (0)
    PG8_STAMP();
    unsigned voffA[2], voffB[2];
#pragma unroll
    for (int i = 0; i < 2; ++i) { int R, C; stage_rc(tid * 16 + i * 8192, R, C); const int Rb = Epi::PERM ? ((R & ~31) + perm32(R & 31)) : R;
        voffA[i] = (unsigned)(R * K + C) * 2u; voffB[i] = (unsigned)(Rb * K + C) * 2u; }
    const size_t kstep = (size_t)(BK * 2);
    const size_t hstep = (size_t)HALF * K * 2;
    const size_t tstep = 2 * hstep;
    const unsigned ldsw = (unsigned)wid * 1024u;
    const int aoff = lds_byte(wr * 64 + fr, fq * 8), boff = lds_byte(wc * 32 + fr, fq * 8);
#define PG8_SA(b, h) (((b) * 2 + (h)) * HTB)
#define PG8_SB(b, h) ((4 + (b) * 2 + (h)) * HTB)
#define PG8_STAGE(bufoff, gbase, voff) do { _Pragma("unroll") for (int _i = 0; _i < 2; ++_i) \
        __builtin_amdgcn_global_load_lds((const unsigned*)((const char*)(gbase) + (voff)[_i]), (PG8_LAS unsigned*)(lds + (bufoff) + ldsw + _i * 8192), 16, 0, 0); } while (0)
#define PG8_LDA(dst, b, h) do { _Pragma("unroll") for (int m = 0; m < 4; ++m) _Pragma("unroll") for (int k = 0; k < 2; ++k) dst[m][k] = *(const PG8_LAS bf16x8*)(lds + PG8_SA(b, h) + aoff + m * 2048 + k * 1024); } while (0)
#define PG8_LDB(dst, b, h) do { _Pragma("unroll") for (int n = 0; n < 2; ++n) _Pragma("unroll") for (int k = 0; k < 2; ++k) dst[n][k] = *(const PG8_LAS bf16x8*)(lds + PG8_SB(b, h) + boff + n * 2048 + k * 1024); } while (0)
#define PG8_MMA(ai, bj, At, Bt) do { __builtin_amdgcn_s_setprio(1); _Pragma("unroll") for (int m = 0; m < 4; ++m) _Pragma("unroll") for (int n = 0; n < 2; ++n) _Pragma("unroll") for (int k = 0; k < 2; ++k) \
        acc[ai][bj][m][n] = __builtin_amdgcn_mfma_f32_16x16x32_bf16(Bt[n][k], At[m][k], acc[ai][bj][m][n], 0, 0, 0); __builtin_amdgcn_s_setprio(0); } while (0)
#define PG8_WAIT_V(n) asm volatile("s_waitcnt vmcnt(" #n ")" ::: "memory")
#define PG8_WAIT_L(n) asm volatile("s_waitcnt lgkmcnt(" #n ")" ::: "memory")
#define PG8_BAR __builtin_amdgcn_s_barrier()
#define PG8_SCHED __builtin_amdgcn_sched_barrier(0)
    Unit cur, nxt; int ui = 0;
    if (!S.next(0, cur)) return;
    f32x4 acc[2][2][4][2];
#pragma unroll
    for (int a = 0; a < 2; ++a)
#pragma unroll
        for (int b = 0; b < 2; ++b)
#pragma unroll
            for (int m = 0; m < 4; ++m)
#pragma unroll
                for (int n = 0; n < 2; ++n) acc[a][b][m][n] = (f32x4){0.f, 0.f, 0.f, 0.f};
    bf16x8 At[4][2], B0[2][2], B1[2][2];
    const char* cA = (const char*)g.A + (size_t)cur.pm * tstep; const char* cB = (const char*)g.Bt + (size_t)cur.pn * tstep;
    S.a_ready(cur);
    PG8_STAGE(PG8_SB(0, 0), cB, voffB); PG8_STAGE(PG8_SA(0, 0), cA, voffA); PG8_STAGE(PG8_SB(0, 1), cB + hstep, voffB); PG8_STAGE(PG8_SA(0, 1), cA + hstep, voffA);
    if (wr == 1) PG8_BAR;
    PG8_WAIT_V(4); PG8_BAR;
    PG8_STAGE(PG8_SB(1, 0), cB + kstep, voffB); PG8_STAGE(PG8_SA(1, 0), cA + kstep, voffA); PG8_STAGE(PG8_SB(1, 1), cB + hstep + kstep, voffB);
    PG8_WAIT_V(6); PG8_BAR;
    PG8_STAMP();
    for (;;) {
        const bool has_next = S.next(ui + 1, nxt);
        const char* nA = has_next ? (const char*)g.A + (size_t)nxt.pm * tstep : cA; const char* nB = has_next ? (const char*)g.Bt + (size_t)nxt.pn * tstep : cB;
        for (int t = 0; t < nt; t += 2) {
            const bool last = (t == nt - 2);
            const char* a1 = cA + (size_t)(t + 1) * kstep;
            const char* a2 = last ? nA : cA + (size_t)(t + 2) * kstep; const char* b2 = last ? nB : cB + (size_t)(t + 2) * kstep;
            const char* a3 = a2 + kstep; const char* b3 = b2 + kstep;
            if (last && has_next) S.a_ready(nxt);
            PG8_LDB(B0, 0, 0); PG8_SCHED; PG8_LDA(At, 0, 0); PG8_STAGE(PG8_SA(1, 1), a1 + hstep, voffA);
            PG8_WAIT_L(8); PG8_BAR; PG8_WAIT_L(0); PG8_MMA(0, 0, At, B0); PG8_BAR; PG8_SCHED;
            PG8_LDB(B1, 0, 1); PG8_STAGE(PG8_SB(0, 0), b2, voffB);
            PG8_BAR; PG8_WAIT_L(0); PG8_MMA(0, 1, At, B1); PG8_BAR;
            PG8_LDA(At, 0, 1); PG8_STAGE(PG8_SA(0, 0), a2, voffA);
            PG8_BAR; PG8_WAIT_L(0); PG8_MMA(1, 0, At, B0); PG8_BAR; PG8_SCHED;
            PG8_STAGE(PG8_SB(0, 1), b2 + hstep, voffB);
            PG8_WAIT_V(6); PG8_BAR; PG8_MMA(1, 1, At, B1); PG8_BAR;
            PG8_LDB(B0, 1, 0); PG8_SCHED; PG8_LDA(At, 1, 0); PG8_STAGE(PG8_SA(0, 1), a2 + hstep, voffA);
            PG8_WAIT_L(8); PG8_BAR; PG8_WAIT_L(0); PG8_MMA(0, 0, At, B0); PG8_BAR; PG8_SCHED;
            PG8_LDB(B1, 1, 1); PG8_STAGE(PG8_SB(1, 0), b3, voffB);
            PG8_BAR; PG8_WAIT_L(0); PG8_MMA(0, 1, At, B1); PG8_BAR;
            PG8_LDA(At, 1, 1); PG8_STAGE(PG8_SA(1, 0), a3, voffA);
            PG8_BAR; PG8_WAIT_L(0); PG8_MMA(1, 0, At, B0); PG8_BAR; PG8_SCHED;
            PG8_STAGE(PG8_SB(1, 1), b3 + hstep, voffB);
            PG8_WAIT_V(6); PG8_BAR; PG8_MMA(1, 1, At, B1); PG8_BAR;
        }
        PG8_STAMP();
        if constexpr (!Epi::AFTER_DRAIN) { E(acc, cur, wr, wc, fr, fq); S.done(cur); }
        PG8_STAMP();
        if (!has_next) break;
#pragma unroll
        for (int a = 0; a < 2; ++a)
#pragma unroll
            for (int b = 0; b < 2; ++b)
#pragma unroll
                for (int m = 0; m < 4; ++m)
#pragma unroll
                    for (int n = 0; n < 2; ++n) acc[a][b][m][n] = (f32x4){0.f, 0.f, 0.f, 0.f};
        cur = nxt; cA = nA; cB = nB; ++ui;
    }
    PG8_WAIT_V(0);
    if (wr == 0) PG8_BAR;
    PG8_BAR;
    if constexpr (Epi::AFTER_DRAIN) { E.fused(acc, cur, wr, wc, fr, fq, lds, wid, lane); S.done(cur); }
    PG8_STAMP();
    if (STAMP && wid == 0) { stamps[lane] = lane < nts ? (((unsigned long long)(unsigned)ts_hi << 32) | (unsigned)ts_lo) : 0ull;
        if (lane == 62) stamps[62] = rt_entry; if (lane == 63) stamps[63] = (unsigned long long)wall_clock64(); }
#undef PG8_STAMP
#undef PG8_SA
#undef PG8_SB
#undef PG8_STAGE
#undef PG8_LDA
#undef PG8_LDB
#undef PG8_MMA
#undef PG8_WAIT_V
#undef PG8_WAIT_L
#undef PG8_BAR
#undef PG8_SCHED
}
}
#define LAS __attribute__((address_space(3)))
typedef unsigned short bf16;
typedef float f32x4 __attribute__((ext_vector_type(4)));
typedef unsigned u32x4 __attribute__((ext_vector_type(4)));
typedef unsigned u32x2 __attribute__((ext_vector_type(2)));
typedef float f32x2 __attribute__((ext_vector_type(2)));
typedef short bf16x8 __attribute__((ext_vector_type(8)));
constexpr int M = 32768, T = 8192, D = 1024, FF = 2816;
constexpr size_t MiB = 1u << 20;
constexpr size_t WS_LB = 0, WS_SSQ1 = 65536, WS_SSQ2 = 65536 + 131072;
constexpr size_t WS_WTIN = 2 * MiB, WS_WTOUT = 10 * MiB, WS_WT13 = 12 * MiB, WS_WT2 = 23 * MiB, WS_LT = 29 * MiB;
constexpr size_t WS_HG = 32 * MiB, WS_RW = 160 * MiB, WS_Y = 272 * MiB, WS_W = 272 * MiB, WS_KK = 336 * MiB, WS_BB = 368 * MiB, WS_KM = 400 * MiB, WS_R = 432 * MiB, WS_V = 464 * MiB;
constexpr size_t WS_GC = 496 * MiB;
constexpr size_t WS_MIX = 160 * MiB, WS_X1B = 272 * MiB, WS_U = 32 * MiB, WS_END = 500 * MiB;
constexpr size_t WS_CA = 160 * MiB, DO_CB = 32 * MiB, WS_CG = 498 * MiB, WS_OH = 336 * MiB;
constexpr int CA_SZ = 14336, CB_SZ = 12288;
constexpr size_t DO_XN = 0, DO_G = 0;
constexpr int LDS_BYTES = 147456;
constexpr int NPHASE = 10;
#ifndef N_LAUNCHES
#define N_LAUNCHES 1
#endif

__device__ __forceinline__ unsigned f2bf(float f) { unsigned u = __float_as_uint(f); return (u + 0x7fffu + ((u >> 16) & 1u)) >> 16; }
__device__ __forceinline__ unsigned pk2(float lo, float hi) { return f2bf(lo) | (f2bf(hi) << 16); }
__device__ __forceinline__ float bflo(unsigned u) { return __uint_as_float(u << 16); }
__device__ __forceinline__ float bfhi(unsigned u) { return __uint_as_float(u & 0xffff0000u); }
__device__ __forceinline__ float bf1(bf16 b) { return __uint_as_float(((unsigned)b) << 16); }
__device__ __forceinline__ float sigmf(float v) { return __builtin_amdgcn_rcpf(1.0f + __expf(-v)); }
__device__ __forceinline__ float wave_sum(float v) {
#pragma unroll
    for (int o = 1; o < 64; o <<= 1) v += __shfl_xor(v, o);
    return v;
}
#define BAR_LDS() do { asm volatile("s_waitcnt lgkmcnt(0)" ::: "memory"); __builtin_amdgcn_s_barrier(); asm volatile("" ::: "memory"); } while (0)
template <int CTRL> __device__ __forceinline__ float dpp_add(float v) { return v + __int_as_float(__builtin_amdgcn_update_dpp(0, __float_as_int(v), CTRL, 0xf, 0xf, true)); }
__device__ __forceinline__ float rowsum16(float v) { v = dpp_add<0xB1>(v); v = dpp_add<0x4E>(v); v = dpp_add<0x141>(v); v = dpp_add<0x140>(v); return v; }

#define XB_TMO      128
#define XB_XCNT(j)  (256  + 64 * (j))
#define XB_XSUB(j)  (1280 + 64 * (j))
#define XB_XGEN(j)  (2304 + 64 * (j))
#define XB_TOP      3328
#define XB_TOPGEN   3392
#define XCD_BAR_WORDS 3456
#define XB_SPIN_CAP (1u << 18)

__device__ __forceinline__ unsigned xb_ld(unsigned* p)              { return __hip_atomic_load(p, __ATOMIC_RELAXED, __HIP_MEMORY_SCOPE_AGENT); }
__device__ __forceinline__ unsigned xb_add(unsigned* p, unsigned v) { return __hip_atomic_fetch_add(p, v, __ATOMIC_RELAXED, __HIP_MEMORY_SCOPE_AGENT); }
__device__ __forceinline__ unsigned xb_xcc_id() { return (unsigned)__builtin_amdgcn_s_getreg((3 << 11) | 20) & 0xFu; }
#define XB_SPIN(cond, bar) do { unsigned _sp = 0; while (cond) { __builtin_amdgcn_s_sleep(1); \
    if ((++_sp & 255u) == 0u) { if (xb_ld(&(bar)[XB_TMO])) break; if (_sp > XB_SPIN_CAP) { atomicAdd(&(bar)[XB_TMO], 1u); break; } } } } while (0)

struct XcdBarrier {
    unsigned* bar; unsigned x;
    volatile LAS unsigned* st;
};

__device__ __forceinline__ XcdBarrier xcd_barrier_post(unsigned* bar, volatile LAS unsigned* st) {
    XcdBarrier b; b.bar = bar; b.x = xb_xcc_id(); b.st = st;
    if (threadIdx.x == 0) (void)xb_add(&bar[XB_XCNT(b.x)], 1u);
    return b;
}
__device__ __forceinline__ void xcd_barrier_complete(unsigned* bar, unsigned x, unsigned& nloc, unsigned& nx) {
    const unsigned G = gridDim.x * gridDim.y * gridDim.z;
    unsigned sum, cnt, mine, sp = 0u;
    for (;;) {
        sum = 0u; cnt = 0u; mine = 0u;
#pragma unroll
        for (unsigned j = 0; j < 16; ++j) { const unsigned c = xb_ld(&bar[XB_XCNT(j)]); sum += c; cnt += (c > 0u) ? 1u : 0u; mine = (j == x) ? c : mine; }
        if (sum == G) break;
        __builtin_amdgcn_s_sleep(1);
        if ((++sp & 255u) == 0u) { if (xb_ld(&bar[XB_TMO])) break; if (sp > XB_SPIN_CAP) { atomicAdd(&bar[XB_TMO], 1u); break; } }
    }
    nloc = mine > 0u ? mine : 1u; nx = cnt > 0u ? cnt : 1u;
}

__device__ __forceinline__ void xcd_barrier(const XcdBarrier& b) {
    asm volatile("s_waitcnt vmcnt(0)" ::: "memory");
    __syncthreads();
    if (threadIdx.x == 0) {
        unsigned* bar = b.bar;
        __builtin_amdgcn_s_waitcnt(0);
        unsigned nloc = b.st[0], nx = b.st[1];
        if (nloc == 0u) { xcd_barrier_complete(bar, b.x, nloc, nx); b.st[0] = nloc; b.st[1] = nx; }
        const unsigned old = xb_add(&bar[XB_XSUB(b.x)], 1u);
        const unsigned gen = old / nloc;
        if (old + 1u == (gen + 1u) * nloc) {
            __builtin_amdgcn_fence(__ATOMIC_RELEASE, "agent");
            asm volatile("s_waitcnt vmcnt(0)" ::: "memory");
            const unsigned og = xb_add(&bar[XB_TOP], 1u);
            const unsigned tg = og / nx;
            if (og + 1u == (tg + 1u) * nx) xb_add(&bar[XB_TOPGEN], 1u);
            else XB_SPIN(xb_ld(&bar[XB_TOPGEN]) == tg, bar);
            __builtin_amdgcn_fence(__ATOMIC_ACQUIRE, "agent");
            xb_add(&bar[XB_XGEN(b.x)], 1u);
            asm volatile("s_waitcnt vmcnt(0)" ::: "memory");
        } else {
            XB_SPIN(xb_ld(&bar[XB_XGEN(b.x)]) == gen, bar);
            __builtin_amdgcn_fence(__ATOMIC_ACQUIRE, "agent");
            asm volatile("s_waitcnt vmcnt(0)" ::: "memory");
        }
    }
    __syncthreads();
}

constexpr size_t WS_BAR = 524288;
struct Args { const float* in[22]; float* out; unsigned char* ws; int ph_lo, ph_hi; };

__device__ __forceinline__ void p0_transpose_item(const float* W, int K, int N, bf16* WT, int ld, int koff, int mode, LAS float* scr, int item, int lane) {
    const int nblk = N / 32, kb = item / nblk, nb = item % nblk, k0 = 64 * kb, n0 = 32 * nb;
#pragma unroll 8
    for (int i = 0; i < 32; ++i) { const int kk = 2 * i + (lane >> 5); scr[kk * 33 + (lane & 31)] = W[(size_t)(k0 + kk) * N + n0 + (lane & 31)]; }
    asm volatile("s_waitcnt lgkmcnt(0)" ::: "memory");
    const int c = lane & 7;
#pragma unroll
    for (int j = 0; j < 4; ++j) { const int n = (lane >> 3) + 8 * j; const LAS float* s = scr + (8 * c) * 33 + n;
        u32x4 o; o.x = pk2(s[0 * 33], s[1 * 33]); o.y = pk2(s[2 * 33], s[3 * 33]); o.z = pk2(s[4 * 33], s[5 * 33]); o.w = pk2(s[6 * 33], s[7 * 33]);
        const int ng = n0 + n, row = mode == 0 ? ng : ((ng >> 2) * 8 + (ng & 3) + (mode == 2 ? 4 : 0));
        *(u32x4*)(WT + (size_t)row * ld + koff + k0 + 8 * c) = o; }
    asm volatile("s_waitcnt lgkmcnt(0)" ::: "memory");
}
__device__ __forceinline__ void phase0(const Args& a, LAS unsigned char* lds) {
    const int tid = threadIdx.x, lane = tid & 63, wave = tid >> 6, gw = blockIdx.x * 8 + wave, NGW = gridDim.x * 8;
    unsigned char* ws = a.ws;
    LAS float* scr = (LAS float*)(lds + wave * 16384);
    constexpr int I_IN = 16 * 120, I_OUT = 16 * 32, I_1 = 16 * 88, I_2 = 44 * 32, I_L = 16, I_G = 32;
    constexpr int NITEMS = I_IN + I_OUT + 2 * I_1 + I_2 + 2 * I_L + I_G;
    for (int it = gw; it < NITEMS; it += NGW) {
        int r = it;
        if (r < I_IN) { p0_transpose_item(a.in[2], 1024, 3840, (bf16*)(ws + WS_WTIN), 1024, 0, 0, scr, r, lane); continue; } r -= I_IN;
        if (r < I_OUT) { p0_transpose_item(a.in[16], 1024, 1024, (bf16*)(ws + WS_WTOUT), 1024, 0, 0, scr, r, lane); continue; } r -= I_OUT;
        if (r < I_1) { p0_transpose_item(a.in[18], 1024, 2816, (bf16*)(ws + WS_WT13), 1024, 0, 1, scr, r, lane); continue; } r -= I_1;
        if (r < I_1) { p0_transpose_item(a.in[19], 1024, 2816, (bf16*)(ws + WS_WT13), 1024, 0, 2, scr, r, lane); continue; } r -= I_1;
        if (r < I_2) { p0_transpose_item(a.in[20], 2816, 1024, (bf16*)(ws + WS_WT2), 2816, 0, 0, scr, r, lane); continue; } r -= I_2;
        if (r < I_L) { p0_transpose_item(a.in[7], 64, 512, (bf16*)(ws + WS_LT), 256, 0, 0, scr, r, lane); continue; } r -= I_L;
        if (r < I_L) { p0_transpose_item(a.in[9], 64, 512, (bf16*)(ws + WS_LT), 256, 64, 0, scr, r, lane); continue; } r -= I_L;
        p0_transpose_item(a.in[10], 128, 512, (bf16*)(ws + WS_LT), 256, 128, 0, scr, r, lane);
    }
    const float* x = a.in[0]; const float* nw = a.in[1]; bf16* XN = (bf16*)((unsigned char*)a.out + DO_XN);
    f32x4 wv[4];
#pragma unroll
    for (int j = 0; j < 4; ++j) wv[j] = *((const f32x4*)nw + 64 * j + lane);
    for (int m = gw; m < M; m += NGW) {
        const f32x4* xr = (const f32x4*)(x + (size_t)m * D) + lane;
        f32x4 v[4]; float s = 0.f;
#pragma unroll
        for (int j = 0; j < 4; ++j) { v[j] = xr[64 * j]; s += (v[j].x * v[j].x + v[j].y * v[j].y) + (v[j].z * v[j].z + v[j].w * v[j].w); }
        const float rstd = __builtin_amdgcn_rsqf(wave_sum(s) * (1.f / D) + 1e-6f);
        u32x2* o8 = (u32x2*)(XN + (size_t)m * D) + lane;
#pragma unroll
        for (int j = 0; j < 4; ++j) { u32x2 o; o.x = pk2(v[j].x * rstd * wv[j].x, v[j].y * rstd * wv[j].y); o.y = pk2(v[j].z * rstd * wv[j].z, v[j].w * rstd * wv[j].w); o8[64 * j] = o; }
    }
    const int gt = blockIdx.x * 512 + tid, NGT = gridDim.x * 512;
    if (gt < 512) { const float* hb = a.in[3]; ((float*)(ws + WS_LB))[gt] = 1.0f / (1.0f + __expf(hb[512 + gt] - hb[gt])); }
    for (int i = gt; i < 2 * M; i += NGT) ((float*)(ws + WS_SSQ1))[i] = 0.f;
}

constexpr int ALD = 264;
__device__ __forceinline__ void phase2(const Args& a, LAS unsigned char* lds) {
    const int tid = threadIdx.x, lane = tid & 63, wave = tid >> 6, tok = lane & 15, q = lane >> 4;
    unsigned char* ws = a.ws;
    const bf16* __restrict__ RW = (const bf16*)(ws + WS_RW); const bf16* __restrict__ LT = (const bf16*)(ws + WS_LT);
    const float* __restrict__ mix = a.in[5]; const float* __restrict__ w0 = a.in[6]; const float* __restrict__ a0 = a.in[8]; const float* __restrict__ k_k = a.in[11]; const float* __restrict__ k_a = a.in[12];
    float* __restrict__ Wd = (float*)(ws + WS_W); bf16* __restrict__ KK = (bf16*)(ws + WS_KK); bf16* __restrict__ BB = (bf16*)(ws + WS_BB); bf16* __restrict__ KM = (bf16*)(ws + WS_KM); bf16* __restrict__ R = (bf16*)(ws + WS_R); bf16* __restrict__ V = (bf16*)(ws + WS_V);
    bf16* __restrict__ G = (bf16*)((unsigned char*)a.out + DO_G);
    LAS bf16* A = (LAS bf16*)lds;
    for (int item = blockIdx.x; item < M / 64; item += gridDim.x) {
        const int row0 = item * 64;
        __syncthreads();
#pragma unroll
        for (int i = 0; i < 4; ++i) {
            const int vi = tid + 512 * i, t = vi >> 5, cg8 = vi & 31, row = row0 + t, col = 1536 + 8 * cg8;
            const u32x4 p = *(const u32x4*)(RW + (size_t)row * 1792 + col);
            u32x4 pp = (u32x4){0u, 0u, 0u, 0u};
            if ((row & (T - 1)) != 0) pp = *(const u32x4*)(RW + (size_t)(row - 1) * 1792 + col);
            const f32x4 m0 = *(const f32x4*)(mix + col), m1 = *(const f32x4*)(mix + col + 4);
            float f[8];
            f[0] = bflo(p.x) + (bflo(pp.x) - bflo(p.x)) * m0.x; f[1] = bfhi(p.x) + (bfhi(pp.x) - bfhi(p.x)) * m0.y;
            f[2] = bflo(p.y) + (bflo(pp.y) - bflo(p.y)) * m0.z; f[3] = bfhi(p.y) + (bfhi(pp.y) - bfhi(p.y)) * m0.w;
            f[4] = bflo(p.z) + (bflo(pp.z) - bflo(p.z)) * m1.x; f[5] = bfhi(p.z) + (bfhi(pp.z) - bfhi(p.z)) * m1.y;
            f[6] = bflo(p.w) + (bflo(pp.w) - bflo(p.w)) * m1.z; f[7] = bfhi(p.w) + (bfhi(pp.w) - bfhi(p.w)) * m1.w;
            if (cg8 < 8) {
#pragma unroll
                for (int j = 0; j < 8; ++j) f[j] = 1.0f - 2.0f * __builtin_amdgcn_rcpf(1.0f + __expf(2.0f * f[j]));
            } else if (cg8 >= 16) {
#pragma unroll
                for (int j = 0; j < 8; ++j) f[j] = sigmf(f[j]);
            }
            u32x4 o; o.x = pk2(f[0], f[1]); o.y = pk2(f[2], f[3]); o.z = pk2(f[4], f[5]); o.w = pk2(f[6], f[7]);
            *(LAS u32x4*)(A + t * ALD + 8 * cg8) = o;
        }
        __syncthreads();
        for (int mt = 0; mt < 4; ++mt) {
            f32x4 aw[4], aa[4], ag[4];
#pragma unroll
            for (int nt = 0; nt < 4; ++nt) { aw[nt] = (f32x4){0.f, 0.f, 0.f, 0.f}; aa[nt] = aw[nt]; ag[nt] = aw[nt]; }
            bf16x8 xf[8];
#pragma unroll
            for (int ks = 0; ks < 8; ++ks) xf[ks] = *(const LAS bf16x8*)(A + (16 * mt + tok) * ALD + 32 * ks + 8 * q);
#pragma unroll
            for (int nt = 0; nt < 4; ++nt) {
                const bf16* lrow = LT + (size_t)(64 * wave + 16 * (tok >> 2) + 4 * nt + (tok & 3)) * 256 + 8 * q;
#pragma unroll
                for (int ks = 0; ks < 8; ++ks) {
                    const bf16x8 wf = *(const bf16x8*)(lrow + 32 * ks);
                    if (ks < 2) aw[nt] = __builtin_amdgcn_mfma_f32_16x16x32_bf16(wf, xf[ks], aw[nt], 0, 0, 0);
                    else if (ks < 4) aa[nt] = __builtin_amdgcn_mfma_f32_16x16x32_bf16(wf, xf[ks], aa[nt], 0, 0, 0);
                    else ag[nt] = __builtin_amdgcn_mfma_f32_16x16x32_bf16(wf, xf[ks], ag[nt], 0, 0, 0);
                }
            }
            const int row = row0 + 16 * mt + tok; const bool hasprev = (row & (T - 1)) != 0;
            const bf16* pr = RW + (size_t)row * 1792; const bf16* ppr = pr - 1792;
            float kkv[4][4], av[4][4]; float ss = 0.f;
#pragma unroll
            for (int nt = 0; nt < 4; ++nt) {
                const int c = 64 * wave + 16 * q + 4 * nt;
                float rr[4], kk[4], vv[4];
#pragma unroll
                for (int part = 0; part < 3; ++part) {
                    const u32x2 p = *(const u32x2*)(pr + 512 * part + c); u32x2 pp = (u32x2){0u, 0u};
                    if (hasprev) pp = *(const u32x2*)(ppr + 512 * part + c);
                    const f32x4 mx = *(const f32x4*)(mix + 512 * part + c);
                    float* dst = part == 0 ? rr : (part == 1 ? kk : vv);
                    dst[0] = bflo(p.x) + (bflo(pp.x) - bflo(p.x)) * mx.x; dst[1] = bfhi(p.x) + (bfhi(pp.x) - bfhi(p.x)) * mx.y;
                    dst[2] = bflo(p.y) + (bflo(pp.y) - bflo(p.y)) * mx.z; dst[3] = bfhi(p.y) + (bfhi(pp.y) - bfhi(p.y)) * mx.w;
                }
                const f32x4 w0v = *(const f32x4*)(w0 + c), a0v = *(const f32x4*)(a0 + c), kkw = *(const f32x4*)(k_k + c), kaw = *(const f32x4*)(k_a + c);
                f32x4 dec; float km[4];
#pragma unroll
                for (int j = 0; j < 4; ++j) {
                    const float z = -(w0v[j] + aw[nt][j]);
                    const float sp = fmaxf(z, 0.f) + __logf(1.0f + __expf(-fabsf(z)));
                    dec[j] = -__expf(-sp - 0.5f);
                    const float al = sigmf(a0v[j] + aa[nt][j]);
                    av[nt][j] = al;
                    kkv[nt][j] = kk[j] * kkw[j]; ss += kkv[nt][j] * kkv[nt][j];
                    km[j] = kk[j] * (1.0f + (al - 1.0f) * kaw[j]);
                }
                const size_t o = (size_t)row * 512 + c;
                *(f32x4*)(Wd + o) = dec;
                u32x2 t2; t2.x = pk2(rr[0], rr[1]); t2.y = pk2(rr[2], rr[3]); *(u32x2*)(R + o) = t2;
                t2.x = pk2(km[0], km[1]); t2.y = pk2(km[2], km[3]); *(u32x2*)(KM + o) = t2;
                t2.x = pk2(vv[0], vv[1]); t2.y = pk2(vv[2], vv[3]); *(u32x2*)(V + o) = t2;
                t2.x = pk2(ag[nt][0], ag[nt][1]); t2.y = pk2(ag[nt][2], ag[nt][3]); *(u32x2*)(G + o) = t2;
            }
            ss += __shfl_xor(ss, 16); ss += __shfl_xor(ss, 32);
            const float inv = 1.0f / fmaxf(sqrtf(ss), 1e-12f);
#pragma unroll
            for (int nt = 0; nt < 4; ++nt) {
                const size_t o = (size_t)row * 512 + 64 * wave + 16 * q + 4 * nt;
                float kn[4];
#pragma unroll
                for (int j = 0; j < 4; ++j) kn[j] = kkv[nt][j] * inv;
                u32x2 t2; t2.x = pk2(kn[0], kn[1]); t2.y = pk2(kn[2], kn[3]); *(u32x2*)(KK + o) = t2;
                t2.x = pk2(-kn[0] * av[nt][0], -kn[1] * av[nt][1]); t2.y = pk2(-kn[2] * av[nt][2], -kn[3] * av[nt][3]); *(u32x2*)(BB + o) = t2;
            }
        }
    }
}
__device__ __forceinline__ void rwkv_scan(const Args& a, LAS unsigned char* lds, int bh, int sl) {
    const int tid = threadIdx.x; unsigned char* ws = a.ws;
    const int b = bh >> 3, h = bh & 7; const size_t m0 = (size_t)b * T; const int c0 = 64 * h;
    const float* Wd = (const float*)(ws + WS_W); const bf16* KK = (const bf16*)(ws + WS_KK); const bf16* BB = (const bf16*)(ws + WS_BB);
    const bf16* KM = (const bf16*)(ws + WS_KM); const bf16* R = (const bf16*)(ws + WS_R); const bf16* V = (const bf16*)(ws + WS_V);
    float* Y = (float*)(ws + WS_Y);
    constexpr int BUF = 5 * 16 * 64 * 4 + 16 * 16 * 4;
    constexpr int NT = T / 16;
    if (tid >= 256) {
        const int lt = tid - 256, st = lt >> 4, l16 = lt & 15, c4 = 4 * l16;
        f32x4 w; u32x2 kk, bb, km, r; bf16 v;
#define RW_LOAD(tile) do { const size_t row = m0 + (size_t)(tile) * 16 + st; const size_t o = row * 512 + c0 + c4; \
        w = *(const f32x4*)(Wd + o); kk = *(const u32x2*)(KK + o); bb = *(const u32x2*)(BB + o); km = *(const u32x2*)(KM + o); r = *(const u32x2*)(R + o); v = V[row * 512 + c0 + 16 * sl + l16]; } while (0)
#define RW_STORE(bufi) do { LAS float* B = (LAS float*)(lds + (bufi) * BUF); const int o = st * 64 + c4; \
        *(LAS f32x4*)(B + o) = w; \
        *(LAS f32x4*)(B + 1024 + o) = (f32x4){bflo(kk.x), bfhi(kk.x), bflo(kk.y), bfhi(kk.y)}; \
        *(LAS f32x4*)(B + 2048 + o) = (f32x4){bflo(bb.x), bfhi(bb.x), bflo(bb.y), bfhi(bb.y)}; \
        *(LAS f32x4*)(B + 3072 + o) = (f32x4){bflo(km.x), bfhi(km.x), bflo(km.y), bfhi(km.y)}; \
        *(LAS f32x4*)(B + 4096 + o) = (f32x4){bflo(r.x), bfhi(r.x), bflo(r.y), bfhi(r.y)}; \
        B[5120 + st * 16 + l16] = bf1(v); } while (0)
        RW_LOAD(0); RW_STORE(0); RW_LOAD(1);
        __syncthreads();
        for (int it = 0; it < NT; ++it) {
            if (it + 1 < NT) RW_STORE((it + 1) & 1);
            if (it + 2 < NT) RW_LOAD(it + 2);
            __syncthreads();
        }
#undef RW_LOAD
#undef RW_STORE
    } else {
        const int wv = tid >> 6, l = tid & 63, rloc = 4 * wv + (l >> 4), kq = l & 15;
        f32x2 S01 = (f32x2){0.f, 0.f}, S23 = S01;
        float* yrow = Y + ((size_t)bh * 64 + 16 * sl + rloc) * T + kq;
        __syncthreads();
        for (int it = 0; it < NT; ++it) {
            const LAS float* B = (const LAS float*)(lds + (it & 1) * BUF);
            float ysel = 0.f;
#pragma unroll 4
            for (int st = 0; st < 16; ++st) {
                const int o = st * 64 + 4 * kq;
                const f32x4 w = *(const LAS f32x4*)(B + o), kk = *(const LAS f32x4*)(B + 1024 + o), bn = *(const LAS f32x4*)(B + 2048 + o), km = *(const LAS f32x4*)(B + 3072 + o), r = *(const LAS f32x4*)(B + 4096 + o);
                const float vv = B[5120 + st * 16 + rloc];
                const f32x2 p2 = S01 * kk.lo + S23 * kk.hi;
                const float sa = rowsum16(p2.x + p2.y);
                const f32x2 sa2 = (f32x2){sa, sa}, vv2 = (f32x2){vv, vv};
                S01 = S01 * w.lo + (sa2 * bn.lo + vv2 * km.lo);
                S23 = S23 * w.hi + (sa2 * bn.hi + vv2 * km.hi);
                const f32x2 y2 = S01 * r.lo + S23 * r.hi;
                const float y = rowsum16(y2.x + y2.y);
                ysel = (kq == st) ? y : ysel;
            }
            yrow[it * 16] = ysel;
            __syncthreads();
        }
    }
}
__device__ __forceinline__ void hgrn_scan(const Args& a, LAS unsigned char* lds, int bh, int sl) {
    const int tid = threadIdx.x; unsigned char* ws = a.ws;
    const int b = bh >> 2, h = bh & 3; const size_t m0 = (size_t)b * T;
    const bf16* HG = (const bf16*)(ws + WS_HG);
    float* OH = (float*)(a.ws + WS_OH);
    constexpr int BUF = 2 * 16 * 128 * 4 + 16 * 16 * 4;
    constexpr int NT = T / 16;
    if (tid >= 256) {
        const int lt = tid - 256, st = lt >> 4, l16 = lt & 15, c8 = 8 * l16;
        u32x4 f, q; bf16 iv;
#define HG_LOAD(tile) do { const bf16* rp = HG + (m0 + (size_t)(tile) * 16 + st) * 2048 + 128 * h; \
        q = *(const u32x4*)(rp + c8); f = *(const u32x4*)(rp + 512 + c8); iv = rp[1024 + 16 * sl + l16]; } while (0)
#define HG_STORE(bufi) do { LAS float* B = (LAS float*)(lds + (bufi) * BUF); const int o = st * 128 + c8; \
        *(LAS f32x4*)(B + o) = (f32x4){bflo(f.x), bfhi(f.x), bflo(f.y), bfhi(f.y)}; *(LAS f32x4*)(B + o + 4) = (f32x4){bflo(f.z), bfhi(f.z), bflo(f.w), bfhi(f.w)}; \
        *(LAS f32x4*)(B + 2048 + o) = (f32x4){bflo(q.x), bfhi(q.x), bflo(q.y), bfhi(q.y)}; *(LAS f32x4*)(B + 2048 + o + 4) = (f32x4){bflo(q.z), bfhi(q.z), bflo(q.w), bfhi(q.w)}; \
        B[4096 + st * 16 + l16] = bf1(iv); } while (0)
        HG_LOAD(0); HG_STORE(0); HG_LOAD(1);
        __syncthreads();
        for (int it = 0; it < NT; ++it) {
            if (it + 1 < NT) HG_STORE((it + 1) & 1);
            if (it + 2 < NT) HG_LOAD(it + 2);
            __syncthreads();
        }
#undef HG_LOAD
#undef HG_STORE
    } else {
        const int wv = tid >> 6, l = tid & 63, rloc = 4 * wv + (l >> 4), kq = l & 15;
        f32x2 S0 = (f32x2){0.f, 0.f}, S1 = S0, S2 = S0, S3 = S0;
        float* orow = OH + ((size_t)bh * 128 + 16 * sl + rloc) * T + kq;
        __syncthreads();
        for (int it = 0; it < NT; ++it) {
            const LAS float* B = (const LAS float*)(lds + (it & 1) * BUF);
            float osel = 0.f;
#pragma unroll 4
            for (int st = 0; st < 16; ++st) {
                const int o = st * 128 + 4 * kq;
                const f32x4 f0 = *(const LAS f32x4*)(B + o), f1 = *(const LAS f32x4*)(B + o + 64), q0 = *(const LAS f32x4*)(B + 2048 + o), q1 = *(const LAS f32x4*)(B + 2048 + o + 64);
                const float iv = B[4096 + st * 16 + rloc];
                const f32x2 iv2 = (f32x2){iv, iv};
                S0 = f0.lo * (S0 - iv2) + iv2; S1 = f0.hi * (S1 - iv2) + iv2; S2 = f1.lo * (S2 - iv2) + iv2; S3 = f1.hi * (S3 - iv2) + iv2;
                const f32x2 p2 = (S0 * q0.lo + S1 * q0.hi) + (S2 * q1.lo + S3 * q1.hi);
                const float p = rowsum16(p2.x + p2.y);
                osel = (kq == st) ? p : osel;
            }
            orow[it * 16] = osel;
            __syncthreads();
        }
    }
}

__device__ __forceinline__ void phase2h(const Args& a) {
    const int tid = threadIdx.x, half = tid >> 8, cp = tid & 255;
    bf16* __restrict__ HG = (bf16*)(a.ws + WS_HG); float* __restrict__ GC = (float*)(a.ws + WS_GC);
    for (int rc = blockIdx.x * 2 + half; rc < M / 32; rc += gridDim.x * 2) {
        bf16* p = HG + (size_t)rc * 32 * 2048 + 2 * cp;
        float g0 = 0.f, g1 = 0.f;
#pragma unroll 8
        for (int t = 0; t < 32; ++t) {
            const unsigned q2 = *(const unsigned*)(p + (size_t)t * 2048), f2 = *(const unsigned*)(p + (size_t)t * 2048 + 512);
            const float f0 = bflo(f2), f1 = bfhi(f2);
            g0 += __logf(f0); g1 += __logf(f1);
            const float e0 = __expf(g0), e1 = __expf(g1);
            *(unsigned*)(p + (size_t)t * 2048) = pk2(bflo(q2) * e0, bfhi(q2) * e1);
            *(unsigned*)(p + (size_t)t * 2048 + 512) = pk2((1.0f - f0) * __builtin_amdgcn_rcpf(e0), (1.0f - f1) * __builtin_amdgcn_rcpf(e1));
        }
        typedef float f32x2_ __attribute__((ext_vector_type(2)));
        *(f32x2_*)(GC + (size_t)rc * 512 + 2 * cp) = (f32x2_){__expf(g0), __expf(g1)};
    }
}

__device__ __forceinline__ bf16x8 ldfrag(const LAS bf16* base, int pitch, int lane) { return *(const LAS bf16x8*)(base + (lane & 15) * pitch + 8 * (lane >> 4)); }
__device__ __forceinline__ void hgrn_seq(const Args& a, LAS unsigned char* lds, int bh) {
    const int tid = threadIdx.x, lane = tid & 63, w = tid >> 6, q = lane >> 4, r16 = lane & 15;
    const int b = bh >> 2, h = bh & 3; const size_t m0 = (size_t)b * T;
    const bf16* __restrict__ HG = (const bf16*)(a.ws + WS_HG); const float* __restrict__ GC = (const float*)(a.ws + WS_GC);
    float* __restrict__ OH = (float*)(a.ws + WS_OH);
    LAS bf16* Qs = (LAS bf16*)lds; LAS bf16* Ks = Qs + 4352; LAS bf16* KT = Ks + 4352; LAS bf16* VT = KT + 5120; LAS bf16* Am = VT + 2 * 5120; LAS bf16* ST = Am + 1280;
    const int lrow = tid >> 4, c8 = (tid & 15) * 8;
    const int swz = 8 * ((lrow >> 3) ^ ((tid & 15) & 3)) + (lrow & 7);
#define HS_SCAT2(dst, v) do { (dst)[0 * 40] = (bf16)((v).x & 0xffffu); (dst)[1 * 40] = (bf16)((v).x >> 16); (dst)[2 * 40] = (bf16)((v).y & 0xffffu); (dst)[3 * 40] = (bf16)((v).y >> 16); \
        (dst)[4 * 40] = (bf16)((v).z & 0xffffu); (dst)[5 * 40] = (bf16)((v).z >> 16); (dst)[6 * 40] = (bf16)((v).w & 0xffffu); (dst)[7 * 40] = (bf16)((v).w >> 16); } while (0)
#define LDSW(base, tile) (*(const LAS bf16x8*)((base) + (16 * (tile) + r16) * 40 + 8 * (q ^ ((2 * (tile) + (r16 >> 3)) & 3))))
    struct HOps { u32x4 gq, gk, gv; f32x4 gam; };
    HOps o0, o1, o2, o3;
#define HS_LOADG(O, n) do { const bf16* rp = HG + (m0 + (size_t)(n) * 32 + lrow) * 2048 + 128 * h + c8; (O).gq = *(const u32x4*)rp; (O).gk = *(const u32x4*)(rp + 512); (O).gv = *(const u32x4*)(rp + 1024); \
        (O).gam = *(const f32x4*)(GC + ((size_t)b * 256 + (n)) * 512 + 128 * h + 16 * w + 4 * q); } while (0)
#define HS_SCAT_UNUSED(dst, v) do { (dst)[0 * 40] = (bf16)((v).x & 0xffffu); (dst)[1 * 40] = (bf16)((v).x >> 16); (dst)[2 * 40] = (bf16)((v).y & 0xffffu); (dst)[3 * 40] = (bf16)((v).y >> 16); \
        (dst)[4 * 40] = (bf16)((v).z & 0xffffu); (dst)[5 * 40] = (bf16)((v).z >> 16); (dst)[6 * 40] = (bf16)((v).w & 0xffffu); (dst)[7 * 40] = (bf16)((v).w >> 16); } while (0)
#define HS_STOREL(O, n) do { *(LAS u32x4*)(Qs + lrow * 136 + c8) = (O).gq; *(LAS u32x4*)(Ks + lrow * 136 + c8) = (O).gk; \
        LAS bf16* kt = KT + c8 * 40 + swz; HS_SCAT2(kt, (O).gk); LAS bf16* vt = VT + ((n) & 1) * 5120 + c8 * 40 + swz; HS_SCAT2(vt, (O).gv); } while (0)
    f32x4 S[8];
#pragma unroll
    for (int nt = 0; nt < 8; ++nt) S[nt] = (f32x4){0.f, 0.f, 0.f, 0.f};
    for (int i = tid; i < 17408 / 8; i += 512) *(LAS u32x4*)(ST + 8 * i) = (u32x4){0u, 0u, 0u, 0u};
    HS_LOADG(o0, 0); HS_LOADG(o1, 1); HS_LOADG(o2, 2); HS_LOADG(o3, 3); HS_STOREL(o0, 0);
    BAR_LDS();
#define HS_BODY(C, NX, n) do { \
        const LAS bf16* VTc = VT + ((n) & 1) * 5120; \
        if (w < 4) { \
            const int mt = w >> 1, nt = w & 1; f32x4 acc = (f32x4){0.f, 0.f, 0.f, 0.f}; \
            _Pragma("unroll") for (int ks = 0; ks < 4; ++ks) acc = __builtin_amdgcn_mfma_f32_16x16x32_bf16(ldfrag(Qs + 16 * mt * 136 + 32 * ks, 136, lane), ldfrag(Ks + 16 * nt * 136 + 32 * ks, 136, lane), acc, 0, 0, 0); \
            _Pragma("unroll") for (int i = 0; i < 4; ++i) { const int t = 16 * mt + 4 * q + i, sidx = 16 * nt + r16; Am[t * 40 + sidx] = (bf16)f2bf(sidx <= t ? acc[i] : 0.f); } \
        } \
        f32x4 hk[8]; \
        { const bf16x8 kf = LDSW(KT, w); \
          _Pragma("unroll") for (int nt = 0; nt < 8; ++nt) hk[nt] = __builtin_amdgcn_mfma_f32_16x16x32_bf16(kf, LDSW(VTc, nt), (f32x4){0.f, 0.f, 0.f, 0.f}, 0, 0, 0); } \
        f32x4 oa = (f32x4){0.f, 0.f, 0.f, 0.f}, ob = oa; \
        _Pragma("unroll") for (int ks = 0; ks < 4; ++ks) { const bf16x8 sf = ldfrag(ST + 16 * w * 136 + 32 * ks, 136, lane); \
            oa = __builtin_amdgcn_mfma_f32_16x16x32_bf16(ldfrag(Qs + 32 * ks, 136, lane), sf, oa, 0, 0, 0); \
            ob = __builtin_amdgcn_mfma_f32_16x16x32_bf16(ldfrag(Qs + 16 * 136 + 32 * ks, 136, lane), sf, ob, 0, 0, 0); } \
        BAR_LDS(); \
        { const bf16x8 vf = LDSW(VTc, w); \
          oa = __builtin_amdgcn_mfma_f32_16x16x32_bf16(ldfrag(Am, 40, lane), vf, oa, 0, 0, 0); \
          ob = __builtin_amdgcn_mfma_f32_16x16x32_bf16(ldfrag(Am + 16 * 40, 40, lane), vf, ob, 0, 0, 0); } \
        float* op = OH + (((size_t)bh * 256 + (n)) * 128 + 16 * w + r16) * 32 + 4 * q; \
        *(f32x4*)op = oa; *(f32x4*)(op + 16) = ob; \
        _Pragma("unroll") for (int nt = 0; nt < 8; ++nt) { \
            S[nt] = (C).gam * (S[nt] + hk[nt]); \
            u32x2 t2; t2.x = pk2(S[nt][0], S[nt][1]); t2.y = pk2(S[nt][2], S[nt][3]); \
            *(LAS u32x2*)(ST + (16 * nt + r16) * 136 + 16 * w + 4 * q) = t2; } \
        HS_STOREL(NX, (n) + 1); \
        HS_LOADG(C, ((n) + 4 < T / 32 ? (n) + 4 : T / 32 - 1)); \
        BAR_LDS(); } while (0)
    for (int n = 0; n < T / 32; n += 4) { HS_BODY(o0, o1, n); HS_BODY(o1, o2, n + 1); HS_BODY(o2, o3, n + 2); HS_BODY(o3, o0, n + 3); }
#undef HS_BODY
#undef HS_SCAT2
#undef LDSW
#undef HS_LOADG
#undef HS_SCAT
#undef HS_STOREL
}

__device__ __forceinline__ void phase2c(const Args& a, LAS unsigned char* lds) {
    const int tid = threadIdx.x, lane = tid & 63, w = tid >> 6, q = lane >> 4, r16 = lane & 15;
    unsigned char* ws = a.ws;
    const float* __restrict__ LW = (const float*)(ws + WS_W); const bf16* __restrict__ KK = (const bf16*)(ws + WS_KK); const bf16* __restrict__ BB = (const bf16*)(ws + WS_BB);
    const bf16* __restrict__ KM = (const bf16*)(ws + WS_KM); const bf16* __restrict__ R = (const bf16*)(ws + WS_R); const bf16* __restrict__ V = (const bf16*)(ws + WS_V);
    unsigned char* __restrict__ CA = ws + WS_CA; unsigned char* __restrict__ CB = (unsigned char*)a.out + DO_CB; float* __restrict__ CG = (float*)(ws + WS_CG);
    LAS float* Gs = (LAS float*)lds; LAS float* Lm = Gs + 2048;
    LAS bf16* At = (LAS bf16*)(Lm + 32 * 36); LAS bf16* Rt = At + 2304; LAS bf16* Bt_ = Rt + 2304; LAS bf16* Kt_ = Bt_ + 2304;
    LAS bf16* AT = Kt_ + 2304; LAS bf16* VT = AT + 2560; LAS bf16* KhT = VT + 2560; LAS bf16* AKT = KhT + 2560; LAS bf16* TI = AKT + 1280;
    const int t = tid >> 4, c4 = 4 * (tid & 15);
    for (int it = blockIdx.x; it < 8192; it += gridDim.x) {
        const int bh = it & 31, n = it >> 5, b = bh >> 3, h = bh & 7;
        const size_t o = ((size_t)b * T + 32 * n + t) * 512 + 64 * h + c4;
        const f32x4 lw4 = *(const f32x4*)(LW + o);
        const u32x2 kk2 = *(const u32x2*)(KK + o), bb2 = *(const u32x2*)(BB + o), km2 = *(const u32x2*)(KM + o), r2 = *(const u32x2*)(R + o), v2 = *(const u32x2*)(V + o);
        unsigned char* ca = CA + (size_t)it * CA_SZ; unsigned char* cb = CB + (size_t)it * CB_SZ;
        *(LAS f32x4*)(Gs + t * 64 + c4) = lw4;
        BAR_LDS();
        if (tid < 64) { float g = 0.f;
#pragma unroll 8
            for (int tt = 0; tt < 32; ++tt) { g += Gs[tt * 64 + tid]; Gs[tt * 64 + tid] = g; } }
        BAR_LDS();
        {
            const f32x4 g4 = *(const LAS f32x4*)(Gs + t * 64 + c4), gl4 = *(const LAS f32x4*)(Gs + 31 * 64 + c4);
            f32x4 gp4 = (f32x4){0.f, 0.f, 0.f, 0.f}; if (t > 0) gp4 = *(const LAS f32x4*)(Gs + (t - 1) * 64 + c4);
            const float kkf[4] = {bflo(kk2.x), bfhi(kk2.x), bflo(kk2.y), bfhi(kk2.y)}, bbf[4] = {bflo(bb2.x), bfhi(bb2.x), bflo(bb2.y), bfhi(bb2.y)};
            const float kmf[4] = {bflo(km2.x), bfhi(km2.x), bflo(km2.y), bfhi(km2.y)}, rf[4] = {bflo(r2.x), bfhi(r2.x), bflo(r2.y), bfhi(r2.y)};
            float va[4], vr[4], vb[4], vk[4], vbh[4], vkh[4];
#pragma unroll
            for (int j = 0; j < 4; ++j) {
                const float ea = __expf(gp4[j]), eg = __expf(g4[j]), en = __expf(-g4[j]), el = __expf(gl4[j] - g4[j]);
                va[j] = -kkf[j] * ea; vr[j] = rf[j] * eg; vb[j] = -bbf[j] * en; vk[j] = kmf[j] * en; vbh[j] = -bbf[j] * el; vkh[j] = kmf[j] * el;
            }
            u32x2 p; p.x = pk2(va[0], va[1]); p.y = pk2(va[2], va[3]); *(LAS u32x2*)(At + t * 72 + c4) = p;
            p.x = pk2(vr[0], vr[1]); p.y = pk2(vr[2], vr[3]); *(LAS u32x2*)(Rt + t * 72 + c4) = p; *(u32x2*)(ca + 4096 + (t * 64 + c4) * 2) = p;
            p.x = pk2(vb[0], vb[1]); p.y = pk2(vb[2], vb[3]); *(LAS u32x2*)(Bt_ + t * 72 + c4) = p;
            p.x = pk2(vk[0], vk[1]); p.y = pk2(vk[2], vk[3]); *(LAS u32x2*)(Kt_ + t * 72 + c4) = p;
            bf16* bht = (bf16*)(ca + 8192);
            const unsigned vraw[4] = {v2.x & 0xffffu, v2.x >> 16, v2.y & 0xffffu, v2.y >> 16};
#pragma unroll
            for (int j = 0; j < 4; ++j) {
                AT[(c4 + j) * 40 + t] = (bf16)f2bf(va[j]); VT[(c4 + j) * 40 + t] = (bf16)vraw[j]; KhT[(c4 + j) * 40 + t] = (bf16)f2bf(vkh[j]);
                bht[(c4 + j) * 32 + t] = (bf16)f2bf(vbh[j]);
            }
            if (t == 31) *(f32x4*)(CG + (size_t)it * 64 + c4) = (f32x4){__expf(gl4[0]), __expf(gl4[1]), __expf(gl4[2]), __expf(gl4[3])};
        }
        BAR_LDS();
        {
            const int p = w >> 1, mt = w & 1;
            const LAS bf16* Ab = (p < 2) ? At : Rt; const LAS bf16* Bb = (p & 1) ? Kt_ : Bt_;
            const bf16x8 a0 = ldfrag(Ab + 16 * mt * 72, 72, lane), a1 = ldfrag(Ab + 16 * mt * 72 + 32, 72, lane);
#pragma unroll
            for (int nt = 0; nt < 2; ++nt) {
                f32x4 acc = __builtin_amdgcn_mfma_f32_16x16x32_bf16(a0, ldfrag(Bb + 16 * nt * 72, 72, lane), (f32x4){0.f, 0.f, 0.f, 0.f}, 0, 0, 0);
                acc = __builtin_amdgcn_mfma_f32_16x16x32_bf16(a1, ldfrag(Bb + 16 * nt * 72 + 32, 72, lane), acc, 0, 0, 0);
                const int sidx = 16 * nt + r16, tb = 16 * mt + 4 * q;
                float m[4];
#pragma unroll
                for (int i = 0; i < 4; ++i) m[i] = (p < 2 ? (sidx < tb + i) : (sidx <= tb + i)) ? acc[i] : 0.f;
                if (p == 0) {
#pragma unroll
                    for (int i = 0; i < 4; ++i) Lm[(tb + i) * 36 + sidx] = m[i];
                } else if (p == 1) { u32x2 pp; pp.x = pk2(m[0], m[1]); pp.y = pk2(m[2], m[3]); *(LAS u32x2*)(AKT + sidx * 40 + tb) = pp; }
                else { bf16* dst = (bf16*)(p == 2 ? ca + 12288 : cb + 8192);
#pragma unroll
                    for (int i = 0; i < 4; ++i) dst[(tb + i) * 32 + sidx] = (bf16)f2bf(m[i]); }
            }
        }
        BAR_LDS();
        if (w == 0) {
            const int c = lane & 31; float Tc[32];
#pragma unroll
            for (int tt = 0; tt < 32; ++tt) { float acc = (tt == c) ? 1.f : 0.f;
#pragma unroll
                for (int s2 = 0; s2 < tt; ++s2) acc = fmaf(Lm[tt * 36 + s2], Tc[s2], acc);
                Tc[tt] = acc; }
            if (lane < 32) {
#pragma unroll
                for (int tt = 0; tt < 32; ++tt) TI[tt * 40 + c] = (bf16)f2bf(Tc[tt]); }
        }
        BAR_LDS();
        if (w < 4) {
            const bf16x8 af = ldfrag(AT + 16 * w * 40, 40, lane);
#pragma unroll
            for (int nt = 0; nt < 2; ++nt) {
                const f32x4 acc = __builtin_amdgcn_mfma_f32_16x16x32_bf16(af, ldfrag(TI + 16 * nt * 40, 40, lane), (f32x4){0.f, 0.f, 0.f, 0.f}, 0, 0, 0);
                u32x2 pp; pp.x = pk2(acc[0], acc[1]); pp.y = pk2(acc[2], acc[3]);
                *(u32x2*)(ca + ((16 * nt + r16) * 64 + 16 * w + 4 * q) * 2) = pp;
            }
            const int ms = w >> 1, nt = w & 1;
            const f32x4 acc = __builtin_amdgcn_mfma_f32_16x16x32_bf16(ldfrag(AKT + 16 * ms * 40, 40, lane), ldfrag(TI + 16 * nt * 40, 40, lane), (f32x4){0.f, 0.f, 0.f, 0.f}, 0, 0, 0);
            u32x2 pp; pp.x = pk2(acc[0], acc[1]); pp.y = pk2(acc[2], acc[3]);
            *(u32x2*)(cb + 10240 + ((16 * nt + r16) * 32 + 16 * ms + 4 * q) * 2) = pp;
        } else {
            const int tt = tid - 256, row = tt >> 2, part = tt & 3;
            *(u32x4*)(cb + row * 64 + part * 16) = *(const LAS u32x4*)(KhT + row * 40 + part * 8);
            *(u32x4*)(cb + 4096 + row * 64 + part * 16) = *(const LAS u32x4*)(VT + row * 40 + part * 8);
        }
    }
}

__device__ __forceinline__ void rwkv_seq(const Args& a, LAS unsigned char* lds, int bh) {
    const int tid = threadIdx.x, lane = tid & 63, w = tid >> 6, q = lane >> 4, r16 = lane & 15;
    unsigned char* ws = a.ws;
    const unsigned char* __restrict__ CA = ws + WS_CA; const unsigned char* __restrict__ CB = (const unsigned char*)a.out + DO_CB; const float* __restrict__ CG = (const float*)(ws + WS_CG);
    float* __restrict__ Y = (float*)(ws + WS_Y);
    LAS bf16* HT = (LAS bf16*)lds; LAS bf16* UT = HT + 4608; LAS bf16* SL = UT + 2560;
    const int mt1 = w >> 2, mk = w >> 1, ntH = 2 * (w & 1), usel = (w >> 1) & 1, nt1 = ntH + usel;
    int gofs[4], ldst[4]; bool inB[4], val[4];
#pragma unroll
    for (int r = 0; r < 4; ++r) {
        const int idx = tid + 512 * r; val[r] = idx < 1664; inB[r] = idx >= 896;
        int ld;
        if (idx < 896) { const int i2 = idx; gofs[r] = i2 * 16;
            if (i2 < 256) ld = (i2 >> 3) * 72 + (i2 & 7) * 8;
            else if (i2 < 512) ld = 2304 + ((i2 - 256) >> 3) * 72 + ((i2 - 256) & 7) * 8;
            else if (i2 < 768) ld = 4608 + ((i2 - 512) >> 2) * 40 + ((i2 - 512) & 3) * 8;
            else ld = 7168 + ((i2 - 768) >> 2) * 40 + ((i2 - 768) & 3) * 8;
        } else { const int j2 = idx - 896; gofs[r] = j2 * 16;
            if (j2 < 256) ld = 8448 + (j2 >> 2) * 40 + (j2 & 3) * 8;
            else if (j2 < 512) ld = 11008 + ((j2 - 256) >> 2) * 40 + ((j2 - 256) & 3) * 8;
            else if (j2 < 640) ld = 13568 + ((j2 - 512) >> 2) * 40 + ((j2 - 512) & 3) * 8;
            else ld = 14848 + ((j2 - 640) >> 2) * 40 + ((j2 - 640) & 3) * 8;
        }
        ldst[r] = ld;
    }
    u32x4 st[4]; f32x4 gcur, gnx;
#define RS_LOAD(n) do { const size_t it_ = (size_t)(n) * 32 + bh; const unsigned char* ca = CA + it_ * CA_SZ; const unsigned char* cb = CB + it_ * CB_SZ; \
        _Pragma("unroll") for (int r = 0; r < 4; ++r) if (val[r]) st[r] = *(const u32x4*)((inB[r] ? cb : ca) + gofs[r]); \
        gnx = *(const f32x4*)(CG + it_ * 64 + 16 * mk + 4 * q); } while (0)
#define RS_PUT(n) do { LAS bf16* sl = SL + ((n) & 1) * 16128; _Pragma("unroll") for (int r = 0; r < 4; ++r) if (val[r]) *(LAS u32x4*)(sl + ldst[r]) = st[r]; } while (0)
    f32x4 H0 = (f32x4){0.f, 0.f, 0.f, 0.f}, H1 = H0;
    for (int i = tid; i < 4608 / 8; i += 512) *(LAS u32x4*)(HT + 8 * i) = (u32x4){0u, 0u, 0u, 0u};
    RS_LOAD(0); RS_PUT(0); gcur = gnx;
    BAR_LDS();
    for (int n = 0; n < T / 32; ++n) {
        RS_LOAD((n + 1 < T / 32 ? n + 1 : T / 32 - 1));
        const LAS bf16* sl = SL + (n & 1) * 16128;
        const bf16x8 h0 = ldfrag(HT + 16 * nt1 * 72, 72, lane), h1 = ldfrag(HT + 16 * nt1 * 72 + 32, 72, lane);
        const bf16x8 vth0 = ldfrag(sl + 11008 + 16 * ntH * 40, 40, lane), vth1 = ldfrag(sl + 11008 + (16 * ntH + 16) * 40, 40, lane);
        const bf16x8 vtu = usel ? vth1 : vth0;
        f32x4 u = __builtin_amdgcn_mfma_f32_16x16x32_bf16(ldfrag(sl + 14848 + 16 * mt1 * 40, 40, lane), vtu, (f32x4){0.f, 0.f, 0.f, 0.f}, 0, 0, 0);
        u = __builtin_amdgcn_mfma_f32_16x16x32_bf16(ldfrag(sl + 16 * mt1 * 72, 72, lane), h0, u, 0, 0, 0);
        u = __builtin_amdgcn_mfma_f32_16x16x32_bf16(ldfrag(sl + 16 * mt1 * 72 + 32, 72, lane), h1, u, 0, 0, 0);
        f32x4 y = __builtin_amdgcn_mfma_f32_16x16x32_bf16(ldfrag(sl + 13568 + 16 * mt1 * 40, 40, lane), vtu, (f32x4){0.f, 0.f, 0.f, 0.f}, 0, 0, 0);
        y = __builtin_amdgcn_mfma_f32_16x16x32_bf16(ldfrag(sl + 2304 + 16 * mt1 * 72, 72, lane), h0, y, 0, 0, 0);
        y = __builtin_amdgcn_mfma_f32_16x16x32_bf16(ldfrag(sl + 2304 + 16 * mt1 * 72 + 32, 72, lane), h1, y, 0, 0, 0);
        const bf16x8 kh = ldfrag(sl + 8448 + 16 * mk * 40, 40, lane);
        f32x4 hn0 = __builtin_amdgcn_mfma_f32_16x16x32_bf16(kh, vth0, gcur * H0, 0, 0, 0);
        f32x4 hn1 = __builtin_amdgcn_mfma_f32_16x16x32_bf16(kh, vth1, gcur * H1, 0, 0, 0);
        { u32x2 pp; pp.x = pk2(u[0], u[1]); pp.y = pk2(u[2], u[3]); *(LAS u32x2*)(UT + (16 * nt1 + r16) * 40 + 16 * mt1 + 4 * q) = pp; }
        BAR_LDS();
        y = __builtin_amdgcn_mfma_f32_16x16x32_bf16(ldfrag(sl + 7168 + 16 * mt1 * 40, 40, lane), ldfrag(UT + 16 * nt1 * 40, 40, lane), y, 0, 0, 0);
        *(f32x4*)(Y + (((size_t)bh * 256 + n) * 64 + 16 * nt1 + r16) * 32 + 16 * mt1 + 4 * q) = y;
        { const bf16x8 bhf = ldfrag(sl + 4608 + 16 * mk * 40, 40, lane);
          H0 = __builtin_amdgcn_mfma_f32_16x16x32_bf16(bhf, ldfrag(UT + 16 * ntH * 40, 40, lane), hn0, 0, 0, 0);
          H1 = __builtin_amdgcn_mfma_f32_16x16x32_bf16(bhf, ldfrag(UT + (16 * ntH + 16) * 40, 40, lane), hn1, 0, 0, 0);
          u32x2 pp; pp.x = pk2(H0[0], H0[1]); pp.y = pk2(H0[2], H0[3]); *(LAS u32x2*)(HT + (16 * ntH + r16) * 72 + 16 * mk + 4 * q) = pp;
          pp.x = pk2(H1[0], H1[1]); pp.y = pk2(H1[2], H1[3]); *(LAS u32x2*)(HT + (16 * ntH + 16 + r16) * 72 + 16 * mk + 4 * q) = pp; }
        RS_PUT(n + 1); gcur = gnx;
        BAR_LDS();
    }
#undef RS_LOAD
#undef RS_PUT
}
__device__ __forceinline__ void phase3(const Args& a, LAS unsigned char* lds) {
    for (int item = blockIdx.x; item < 48; item += gridDim.x) {
        __syncthreads();
        if (item < 32) rwkv_seq(a, lds, item); else hgrn_seq(a, lds, item - 32);
    }
}

__device__ __forceinline__ float red8(float v) { v = dpp_add<0xB1>(v); v = dpp_add<0x4E>(v); v = dpp_add<0x141>(v); return v; }
__device__ __forceinline__ void phase4(const Args& a, LAS unsigned char* lds) {
    const int tid = threadIdx.x, lane = tid & 63, wave = tid >> 6, gw = blockIdx.x * 8 + wave, NGW = gridDim.x * 8, tk = lane >> 3, cg = lane & 7;
    unsigned char* ws = a.ws;
    bf16* __restrict__ MIX = (bf16*)(ws + WS_MIX);
    const float* __restrict__ Y = (const float*)(ws + WS_Y); const float* __restrict__ OH = (const float*)(a.ws + WS_OH);
    const bf16* __restrict__ R = (const bf16*)(ws + WS_R); const bf16* __restrict__ KM = (const bf16*)(ws + WS_KM); const bf16* __restrict__ V = (const bf16*)(ws + WS_V); const bf16* __restrict__ G = (const bf16*)((unsigned char*)a.out + DO_G);
    const bf16* __restrict__ HG = (const bf16*)(ws + WS_HG);
    const float* __restrict__ r_k = a.in[13]; const float* __restrict__ ln_w = a.in[14]; const float* __restrict__ ln_b = a.in[15]; const float* __restrict__ hnw = a.in[4];
    LAS float* Yt = (LAS float*)(lds + wave * 17408);
    constexpr int N_RW = 32 * 128, N_HG = 16 * 128;
    for (int it = gw; it < N_RW + N_HG; it += NGW) {
        if (it < N_RW) {
            const int bh = it >> 7, tile = it & 127, b = bh >> 3, h = bh & 7, t0 = tile * 64;
            const float* yp = Y + ((size_t)bh * 256 + 2 * tile + (lane >> 5)) * 64 * 32 + (lane & 31);
#pragma unroll 16
            for (int v = 0; v < 64; ++v) Yt[v * 65 + lane] = yp[v * 32];
            asm volatile("s_waitcnt lgkmcnt(0)" ::: "memory");
            const int c = 64 * h + 8 * cg;
            const f32x4 k0 = *(const f32x4*)(r_k + c), k1 = *(const f32x4*)(r_k + c + 4), w0 = *(const f32x4*)(ln_w + c), w1 = *(const f32x4*)(ln_w + c + 4), b0 = *(const f32x4*)(ln_b + c), b1 = *(const f32x4*)(ln_b + c + 4);
            const float kr[8] = {k0.x, k0.y, k0.z, k0.w, k1.x, k1.y, k1.z, k1.w}, lw[8] = {w0.x, w0.y, w0.z, w0.w, w1.x, w1.y, w1.z, w1.w}, lb[8] = {b0.x, b0.y, b0.z, b0.w, b1.x, b1.y, b1.z, b1.w};
#pragma unroll 2
            for (int i = 0; i < 8; ++i) {
                const int tok = 8 * i + tk; const size_t row = (size_t)b * T + t0 + tok, o = row * 512 + c;
                const u32x4 rr = *(const u32x4*)(R + o), kk = *(const u32x4*)(KM + o), vv = *(const u32x4*)(V + o), gg = *(const u32x4*)(G + o);
                float y[8]; float s = 0.f;
#pragma unroll
                for (int j = 0; j < 8; ++j) { y[j] = Yt[(8 * cg + j) * 65 + tok]; s += y[j]; }
                const float mu = red8(s) * (1.f / 64.f); float q = 0.f;
#pragma unroll
                for (int j = 0; j < 8; ++j) { y[j] -= mu; q += y[j] * y[j]; }
                const float rs = __builtin_amdgcn_rsqf(red8(q) * (1.f / 64.f) + 64e-5f);
                const float rv[8] = {bflo(rr.x), bfhi(rr.x), bflo(rr.y), bfhi(rr.y), bflo(rr.z), bfhi(rr.z), bflo(rr.w), bfhi(rr.w)};
                const float kv[8] = {bflo(kk.x), bfhi(kk.x), bflo(kk.y), bfhi(kk.y), bflo(kk.z), bfhi(kk.z), bflo(kk.w), bfhi(kk.w)};
                const float vf[8] = {bflo(vv.x), bfhi(vv.x), bflo(vv.y), bfhi(vv.y), bflo(vv.z), bfhi(vv.z), bflo(vv.w), bfhi(vv.w)};
                const float gf[8] = {bflo(gg.x), bfhi(gg.x), bflo(gg.y), bfhi(gg.y), bflo(gg.z), bfhi(gg.z), bflo(gg.w), bfhi(gg.w)};
                float dot = 0.f;
#pragma unroll
                for (int j = 0; j < 8; ++j) dot += rv[j] * kv[j] * kr[j];
                dot = red8(dot);
                float e[8];
#pragma unroll
                for (int j = 0; j < 8; ++j) e[j] = (y[j] * rs * lw[j] + lb[j] + dot * vf[j]) * gf[j];
                u32x4 ov; ov.x = pk2(e[0], e[1]); ov.y = pk2(e[2], e[3]); ov.z = pk2(e[4], e[5]); ov.w = pk2(e[6], e[7]);
                *(u32x4*)(MIX + row * 1024 + 512 + c) = ov;
            }
            asm volatile("s_waitcnt lgkmcnt(0)" ::: "memory");
        } else {
            const int i2 = it - N_RW, bh = i2 >> 7, tile = i2 & 127, b = bh >> 2, h = bh & 3, t0 = tile * 64;
            const float* op = OH + ((size_t)bh * 256 + 2 * tile + (lane >> 5)) * 128 * 32 + (lane & 31);
            float ss = 0.f;
#pragma unroll 16
            for (int v = 0; v < 128; ++v) { const float o = op[v * 32]; ss += o * o; }
            Yt[64 * 65 + lane] = __builtin_amdgcn_rsqf(ss * (1.f / 128.f) + 1e-6f);
            for (int half = 0; half < 2; ++half) {
#pragma unroll 16
                for (int v = 0; v < 64; ++v) Yt[v * 65 + lane] = op[(64 * half + v) * 32];
                asm volatile("s_waitcnt lgkmcnt(0)" ::: "memory");
                const int c = 128 * h + 64 * half + 8 * cg;
                const f32x4 w0 = *(const f32x4*)(hnw + c), w1 = *(const f32x4*)(hnw + c + 4);
                const float wv[8] = {w0.x, w0.y, w0.z, w0.w, w1.x, w1.y, w1.z, w1.w};
#pragma unroll 2
                for (int i = 0; i < 8; ++i) {
                    const int tok = 8 * i + tk; const size_t row = (size_t)b * T + t0 + tok;
                    const u32x4 gg = *(const u32x4*)(HG + row * 2048 + 1536 + c);
                    const float rs = Yt[64 * 65 + tok];
                    const float gf[8] = {bflo(gg.x), bfhi(gg.x), bflo(gg.y), bfhi(gg.y), bflo(gg.z), bfhi(gg.z), bflo(gg.w), bfhi(gg.w)};
                    float e[8];
#pragma unroll
                    for (int j = 0; j < 8; ++j) e[j] = Yt[(8 * cg + j) * 65 + tok] * rs * wv[j] * gf[j] * sigmf(gf[j]);
                    u32x4 ov; ov.x = pk2(e[0], e[1]); ov.y = pk2(e[2], e[3]); ov.z = pk2(e[4], e[5]); ov.w = pk2(e[6], e[7]);
                    *(u32x4*)(MIX + row * 1024 + c) = ov;
                }
                asm volatile("s_waitcnt lgkmcnt(0)" ::: "memory");
            }
        }
    }
}

__device__ __forceinline__ void phase8(const Args& a) {
    const int tid = threadIdx.x, lane = tid & 63, wave = tid >> 6, gw = blockIdx.x * 8 + wave, NGW = gridDim.x * 8;
    const float* fw = a.in[21]; const float* ssq = (const float*)(a.ws + WS_SSQ2);
    f32x4 wv[4];
#pragma unroll
    for (int j = 0; j < 4; ++j) wv[j] = *((const f32x4*)fw + 64 * j + lane);
    for (int m = gw; m < M; m += NGW) {
        const float rstd = __builtin_amdgcn_rsqf(ssq[m] * (1.f / D) + 1e-6f);
        f32x4* xr = (f32x4*)(a.out + (size_t)m * D) + lane;
#pragma unroll
        for (int j = 0; j < 4; ++j) { f32x4 v = xr[64 * j]; v = v * rstd * wv[j]; xr[64 * j] = v; }
    }
}

__global__ void __launch_bounds__(512, 2) fwd_kernel(Args a) {
    extern __shared__ __attribute__((aligned(16))) unsigned char lds_raw[];
    LAS unsigned char* lds = (LAS unsigned char*)lds_raw;
    cg::grid_group grid = cg::this_grid();
    unsigned char* ws = a.ws;
    volatile LAS unsigned* bst = (volatile LAS unsigned*)(lds + LDS_BYTES - 16);
    if (threadIdx.x < 4) bst[threadIdx.x] = 0u;
    __syncthreads();
    XcdBarrier xbar = xcd_barrier_post((unsigned*)(ws + WS_BAR), bst);
    const int lo = a.ph_lo, hi = a.ph_hi;
#define IN(k) (lo <= (k) && (k) < hi)
#define SEAM(k) do { if ((k) + 1 < hi) { if ((k) == 0) grid.sync(); else xcd_barrier(xbar); } } while (0)
    {
        if (IN(0)) { phase0(a, lds); SEAM(0); }
        if (IN(1)) {
            pg8::Gemm g{(const pg8::bf16_t*)((unsigned char*)a.out + DO_XN), (const pg8::bf16_t*)(ws + WS_WTIN), M, 3840, 1024}; pg8::StaticOrder S; S.init(M, 3840, gridDim.x, blockIdx.x);
            pg8::EpiProj E{(pg8::bf16_t*)(ws + WS_HG), (pg8::bf16_t*)(ws + WS_RW), (const float*)(ws + WS_LB)};
            pg8::gemm_phase<pg8::EpiProj, pg8::StaticOrder>((PG8_LAS unsigned char*)lds, g, S, E, nullptr); SEAM(1);
        }
        if (IN(2)) { phase2(a, lds); phase2h(a); SEAM(2); }
        if (IN(3)) { phase2c(a, lds); SEAM(3); }
        if (IN(4)) { phase3(a, lds); SEAM(4); }
        if (IN(5)) { phase4(a, lds); SEAM(5); }
        if (IN(6)) {
            pg8::Gemm g{(const pg8::bf16_t*)(ws + WS_MIX), (const pg8::bf16_t*)(ws + WS_WTOUT), M, 1024, 1024}; pg8::StaticOrder S; S.init(M, 1024, gridDim.x, blockIdx.x);
            pg8::EpiRes<true> E{a.in[0], a.out, (pg8::bf16_t*)(ws + WS_X1B), a.in[17], (float*)(ws + WS_SSQ1)};
            pg8::gemm_phase<pg8::EpiRes<true>, pg8::StaticOrder>((PG8_LAS unsigned char*)lds, g, S, E, nullptr); SEAM(6);
        }
        if (IN(7)) {
            pg8::Gemm g{(const pg8::bf16_t*)(ws + WS_X1B), (const pg8::bf16_t*)(ws + WS_WT13), M, 2 * FF, 1024}; pg8::StaticOrder S; S.init(M, 2 * FF, gridDim.x, blockIdx.x);
            pg8::EpiGlu E{(pg8::bf16_t*)(ws + WS_U), (const float*)(ws + WS_SSQ1)};
            pg8::gemm_phase<pg8::EpiGlu, pg8::StaticOrder>((PG8_LAS unsigned char*)lds, g, S, E, nullptr); SEAM(7);
        }
        if (IN(8)) {
            pg8::Gemm g{(const pg8::bf16_t*)(ws + WS_U), (const pg8::bf16_t*)(ws + WS_WT2), M, 1024, FF}; pg8::StaticOrder S; S.init(M, 1024, gridDim.x, blockIdx.x);
            pg8::EpiRes<false> E{a.out, a.out, nullptr, nullptr, (float*)(ws + WS_SSQ2)};
            pg8::gemm_phase<pg8::EpiRes<false>, pg8::StaticOrder>((PG8_LAS unsigned char*)lds, g, S, E, nullptr); SEAM(8);
        }
        if (IN(9)) phase8(a);
    }
#undef IN
#undef SEAM
}

extern "C" void kernel_launch(void* const* d_in, const int* in_sizes, int n_in, void* d_out, int out_size, void* d_ws, size_t ws_size, hipStream_t stream) {
    static int grid = 0;
    if (grid == 0) {
        if (n_in != 22 || out_size != M * D || ws_size < WS_END) { fprintf(stderr, "kernel_launch: unexpected problem (n_in %d, out %d, ws %zu)\n", n_in, out_size, ws_size); grid = -1; return; }
        int dev = 0, cus = 0, per_cu = 0;
        if (hipGetDevice(&dev) != hipSuccess || hipDeviceGetAttribute(&cus, hipDeviceAttributeMultiprocessorCount, dev) != hipSuccess) { grid = -1; return; }
        if (hipFuncSetAttribute((const void*)fwd_kernel, hipFuncAttributeMaxDynamicSharedMemorySize, LDS_BYTES) != hipSuccess) { fprintf(stderr, "kernel_launch: hipFuncSetAttribute failed\n"); grid = -1; return; }
        if (hipOccupancyMaxActiveBlocksPerMultiprocessor(&per_cu, (const void*)fwd_kernel, 512, LDS_BYTES) != hipSuccess || per_cu < 1) { fprintf(stderr, "kernel_launch: occupancy query says %d\n", per_cu); per_cu = 1; }
        (void)hipGetLastError();
        grid = cus * 1;
    }
    if (grid < 0) return;
    if (hipMemsetAsync((char*)d_ws + WS_BAR, 0, 16384, stream) != hipSuccess) { fprintf(stderr, "kernel_launch: memset failed\n"); return; }
    Args a{};
    for (int i = 0; i < 22; ++i) a.in[i] = (const float*)d_in[i];
    a.out = (float*)d_out; a.ws = (unsigned char*)d_ws;
    if (N_LAUNCHES == 1) {
        a.ph_lo = 0; a.ph_hi = NPHASE;
        void* args[] = {&a};
        hipError_t e = hipLaunchCooperativeKernel((const void*)fwd_kernel, dim3(grid), dim3(512), args, LDS_BYTES, stream);
        if (e != hipSuccess) fprintf(stderr, "cooperative launch failed: %s (grid %d)\n", hipGetErrorString(e), grid);
    } else {
        for (int ph = 0; ph < NPHASE; ++ph) { a.ph_lo = ph; a.ph_hi = ph + 1; hipLaunchKernelGGL(fwd_kernel, dim3(grid), dim3(512), LDS_BYTES, stream, a);
#ifdef PROBE_DUP
            if (ph == PROBE_DUP) hipLaunchKernelGGL(fwd_kernel, dim3(grid), dim3(512), LDS_BYTES, stream, a);
#endif
        }
    }
}
```

```cpp
#include <hip/hip_runtime.h>
#include <hip/hip_cooperative_groups.h>
#include <cstdio>
namespace cg = cooperative_groups;
namespace pg8 {
#define PG8_LAS __attribute__((address_space(3)))
typedef unsigned short bf16_t;
typedef short bf16x8 __attribute__((ext_vector_type(8)));
typedef float f32x4 __attribute__((ext_vector_type(4)));
typedef unsigned u32x4 __attribute__((ext_vector_type(4)));
constexpr int BM = 256, BK = 64, HALF = 128, HTB = HALF * BK * 2  , STAGE_BYTES = 8 * HTB, NXCD = 8, WGM = 8;

__host__ __device__ __forceinline__ int lds_byte(int r, int c) { const int st = (r >> 4) * 2 + (c >> 5), rr = r & 15, cc = c & 31, ob = rr * 64 + cc * 2; return st * 1024 + (ob ^ (((ob >> 9) & 1) << 5)); }
__host__ __device__ __forceinline__ void stage_rc(int b, int& R, int& C) { const int st = b / 1024, sb = b % 1024, swz = sb ^ (((sb >> 9) & 1) << 5); R = (st >> 1) * 16 + swz / 64; C = (st & 1) * 32 + (swz % 64) / 2; }
__host__ __device__ __forceinline__ int perm32(int rho) { const int n = rho >> 4, i = rho & 15; return 8 * (i >> 2) + 4 * n + (i & 3); }

struct Unit { int pm, pn; };
struct Gemm { const bf16_t* A; const bf16_t* Bt; int M, N, K; };

struct StaticOrder {
    int nM, nN, nwg, G, c;
    __host__ __device__ void init(int M, int N, int G_, int c_) { nM = M / BM; nN = N / BM; nwg = nM * nN; G = G_; c = c_; }
    __host__ __device__ bool next(int i, Unit& u) const {
        const long L = (long)i * G + c; if (L >= nwg) return false;
        int wgid = (int)L; { const int q = nwg / NXCD, r = nwg % NXCD, xcd = wgid % NXCD, off = wgid / NXCD; wgid = (xcd < r ? xcd * (q + 1) : r * (q + 1) + (xcd - r) * q) + off; }
        const int nig = WGM * nN, gid = wgid / nig, fm = gid * WGM, gsz = (nM - fm) < WGM ? (nM - fm) : WGM;
        u.pm = fm + ((wgid % nig) % gsz); u.pn = (wgid % nig) / gsz; return true;
    }
    __device__ __forceinline__ void a_ready(const Unit&) const {}
    __device__ __forceinline__ void done(const Unit&) const {}
};
__device__ __forceinline__ unsigned cvt_pk_bf16(float lo, float hi) { unsigned r; asm volatile("v_cvt_pk_bf16_f32 %0, %1, %2" : "=v"(r) : "v"(lo), "v"(hi)); return r; }
__device__ __forceinline__ float sigm(float v) { return __builtin_amdgcn_rcpf(1.0f + __expf(-v)); }
struct EpiProj {
    static constexpr bool PERM = true, AFTER_DRAIN = false;
    bf16_t* HG; bf16_t* RW; const float* LB;
    __device__ __forceinline__ void operator()(const f32x4 (&acc)[2][2][4][2], const Unit& u, int wr, int wc, int fr, int fq) const {
        const int row0 = u.pm * BM + wr * 64 + fr, cb = u.pn * BM + wc * 32 + 8 * fq;
        const int mode = u.pn < 2 ? 0 : (u.pn < 4 ? 1 : 2);
#pragma unroll
        for (int bj = 0; bj < 2; ++bj) {
            const int col = cb + bj * HALF;
            f32x4 l0 = (f32x4){0.f, 0.f, 0.f, 0.f}, l1 = l0;
            if (mode == 1) { l0 = *(const f32x4*)(LB + col - 512); l1 = *(const f32x4*)(LB + col - 512 + 4); }
#pragma unroll
            for (int ai = 0; ai < 2; ++ai)
#pragma unroll
                for (int m = 0; m < 4; ++m) {
                    const int row = row0 + ai * HALF + m * 16;
                    f32x4 v0 = acc[ai][bj][m][0], v1 = acc[ai][bj][m][1];
                    if (mode == 0) {
#pragma unroll
                        for (int j = 0; j < 4; ++j) { v0[j] = v0[j] * sigm(v0[j]); v1[j] = v1[j] * sigm(v1[j]); }
                    } else if (mode == 1) {
#pragma unroll
                        for (int j = 0; j < 4; ++j) { v0[j] = l0[j] + (1.0f - l0[j]) * sigm(v0[j]); v1[j] = l1[j] + (1.0f - l1[j]) * sigm(v1[j]); }
                    }
                    u32x4 w; w.x = cvt_pk_bf16(v0[0], v0[1]); w.y = cvt_pk_bf16(v0[2], v0[3]); w.z = cvt_pk_bf16(v1[0], v1[1]); w.w = cvt_pk_bf16(v1[2], v1[3]);
                    bf16_t* dst = (u.pn < 8) ? HG + (size_t)row * 2048 + col : RW + (size_t)row * 1792 + (col - 2048);
                    *(u32x4*)dst = w;
                }
        }
    }
};
template <bool WB> struct EpiRes {
    static constexpr bool PERM = true, AFTER_DRAIN = false;
    const float* X; float* X1; bf16_t* X1B; const float* NW; float* SSQ;
    __device__ __forceinline__ void operator()(const f32x4 (&acc)[2][2][4][2], const Unit& u, int wr, int wc, int fr, int fq) const {
        const int row0 = u.pm * BM + wr * 64 + fr, cb = u.pn * BM + wc * 32 + 8 * fq;
#pragma unroll
        for (int ai = 0; ai < 2; ++ai)
#pragma unroll
            for (int m = 0; m < 4; ++m) {
                const int row = row0 + ai * HALF + m * 16; float ss = 0.f;
#pragma unroll
                for (int bj = 0; bj < 2; ++bj) {
                    const size_t off = (size_t)row * 1024 + cb + bj * HALF;
                    f32x4 v0 = acc[ai][bj][m][0] + *(const f32x4*)(X + off), v1 = acc[ai][bj][m][1] + *(const f32x4*)(X + off + 4);
                    *(f32x4*)(X1 + off) = v0; *(f32x4*)(X1 + off + 4) = v1;
                    ss += (v0[0] * v0[0] + v0[1] * v0[1]) + (v0[2] * v0[2] + v0[3] * v0[3]) + (v1[0] * v1[0] + v1[1] * v1[1]) + (v1[2] * v1[2] + v1[3] * v1[3]);
                    if (WB) { const f32x4 n0 = *(const f32x4*)(NW + cb + bj * HALF), n1 = *(const f32x4*)(NW + cb + bj * HALF + 4);
                        u32x4 w; w.x = cvt_pk_bf16(v0[0] * n0[0], v0[1] * n0[1]); w.y = cvt_pk_bf16(v0[2] * n0[2], v0[3] * n0[3]); w.z = cvt_pk_bf16(v1[0] * n1[0], v1[1] * n1[1]); w.w = cvt_pk_bf16(v1[2] * n1[2], v1[3] * n1[3]);
                        *(u32x4*)(X1B + off) = w; }
                }
                ss += __shfl_xor(ss, 16); ss += __shfl_xor(ss, 32);
                if (fq == 0) unsafeAtomicAdd(SSQ + row, ss);
            }
    }
};
struct EpiGlu {
    static constexpr bool PERM = true, AFTER_DRAIN = false;
    bf16_t* U; const float* SSQ;
    __device__ __forceinline__ void operator()(const f32x4 (&acc)[2][2][4][2], const Unit& u, int wr, int wc, int fr, int fq) const {
        const int row0 = u.pm * BM + wr * 64 + fr, cb = (u.pn * BM + wc * 32 + 8 * fq) >> 1;
#pragma unroll
        for (int ai = 0; ai < 2; ++ai)
#pragma unroll
            for (int m = 0; m < 4; ++m) {
                const int row = row0 + ai * HALF + m * 16;
                const float rstd = __builtin_amdgcn_rsqf(SSQ[row] * (1.0f / 1024.0f) + 1e-6f);
#pragma unroll
                for (int bj = 0; bj < 2; ++bj) {
                    const f32x4 g = acc[ai][bj][m][0] * rstd, up = acc[ai][bj][m][1] * rstd; float h[4];
#pragma unroll
                    for (int j = 0; j < 4; ++j) h[j] = g[j] * sigm(g[j]) * up[j];
                    typedef unsigned u32x2 __attribute__((ext_vector_type(2)));
                    u32x2 w; w.x = cvt_pk_bf16(h[0], h[1]); w.y = cvt_pk_bf16(h[2], h[3]);
                    *(u32x2*)(U + (size_t)row * 2816 + cb + bj * (HALF / 2)) = w;
                }
            }
    }
};

template <class Epi, class Sched, bool STAMP = false>
__device__ __forceinline__ void gemm_phase(PG8_LAS unsigned char* lds, const Gemm g, const Sched& S, const Epi& E, unsigned long long* stamps) {
    const int tid = threadIdx.x, wid = __builtin_amdgcn_readfirstlane(tid >> 6), lane = tid & 63, wr = wid >> 2, wc = wid & 3, fr = lane & 15, fq = lane >> 4;
    const int K = g.K, nt = K / BK;
    int ts_lo = 0, ts_hi = 0, nts = 0; const unsigned long long rt_entry = STAMP ? (unsigned long long)wall_clock64() : 0ull;
#define PG8_STAMP() do { if (STAMP && wid == 0 && nts < 64) { const unsigned long long _c = (unsigned long long)clock64(); \
        ts_lo = (lane == nts) ? (int)(unsigned)_c : ts_lo; ts_hi = (lane == nts) ? (int)(unsigned)(_c >> 32) : ts_hi; ++nts; } } while (0)
    PG8_STAMP();
    unsigned voffA[2], voffB[2];
#pragma unroll
    for (int i = 0; i < 2; ++i) { int R, C; stage_rc(tid * 16 + i * 8192, R, C); const int Rb = Epi::PERM ? ((R & ~31) + perm32(R & 31)) : R;
        voffA[i] = (unsigned)(R * K + C) * 2u; voffB[i] = (unsigned)(Rb * K + C) * 2u; }
    const size_t kstep = (size_t)(BK * 2);
    const size_t hstep = (size_t)HALF * K * 2;
    const size_t tstep = 2 * hstep;
    const unsigned ldsw = (unsigned)wid * 1024u;
    const int aoff = lds_byte(wr * 64 + fr, fq * 8), boff = lds_byte(wc * 32 + fr, fq * 8);
#define PG8_SA(b, h) (((b) * 2 + (h)) * HTB)
#define PG8_SB(b, h) ((4 + (b) * 2 + (h)) * HTB)
#define PG8_STAGE(bufoff, gbase, voff) do { _Pragma("unroll") for (int _i = 0; _i < 2; ++_i) \
        __builtin_amdgcn_global_load_lds((const unsigned*)((const char*)(gbase) + (voff)[_i]), (PG8_LAS unsigned*)(lds + (bufoff) + ldsw + _i * 8192), 16, 0, 0); } while (0)
#define PG8_LDA(dst, b, h) do { _Pragma("unroll") for (int m = 0; m < 4; ++m) _Pragma("unroll") for (int k = 0; k < 2; ++k) dst[m][k] = *(const PG8_LAS bf16x8*)(lds + PG8_SA(b, h) + aoff + m * 2048 + k * 1024); } while (0)
#define PG8_LDB(dst, b, h) do { _Pragma("unroll") for (int n = 0; n < 2; ++n) _Pragma("unroll") for (int k = 0; k < 2; ++k) dst[n][k] = *(const PG8_LAS bf16x8*)(lds + PG8_SB(b, h) + boff + n * 2048 + k * 1024); } while (0)
#define PG8_MMA(ai, bj, At, Bt) do { __builtin_amdgcn_s_setprio(1); _Pragma("unroll") for (int m = 0; m < 4; ++m) _Pragma("unroll") for (int n = 0; n < 2; ++n) _Pragma("unroll") for (int k = 0; k < 2; ++k) \
        acc[ai][bj][m][n] = __builtin_amdgcn_mfma_f32_16x16x32_bf16(Bt[n][k], At[m][k], acc[ai][bj][m][n], 0, 0, 0); __builtin_amdgcn_s_setprio(0); } while (0)
#define PG8_WAIT_V(n) asm volatile("s_waitcnt vmcnt(" #n ")" ::: "memory")
#define PG8_WAIT_L(n) asm volatile("s_waitcnt lgkmcnt(" #n ")" ::: "memory")
#define PG8_BAR __builtin_amdgcn_s_barrier()
#define PG8_SCHED __builtin_amdgcn_sched_barrier(0)
    Unit cur, nxt; int ui = 0;
    if (!S.next(0, cur)) return;
    f32x4 acc[2][2][4][2];
#pragma unroll
    for (int a = 0; a < 2; ++a)
#pragma unroll
        for (int b = 0; b < 2; ++b)
#pragma unroll
            for (int m = 0; m < 4; ++m)
#pragma unroll
                for (int n = 0; n < 2; ++n) acc[a][b][m][n] = (f32x4){0.f, 0.f, 0.f, 0.f};
    bf16x8 At[4][2], B0[2][2], B1[2][2];
    const char* cA = (const char*)g.A + (size_t)cur.pm * tstep; const char* cB = (const char*)g.Bt + (size_t)cur.pn * tstep;
    S.a_ready(cur);
    PG8_STAGE(PG8_SB(0, 0), cB, voffB); PG8_STAGE(PG8_SA(0, 0), cA, voffA); PG8_STAGE(PG8_SB(0, 1), cB + hstep, voffB); PG8_STAGE(PG8_SA(0, 1), cA + hstep, voffA);
    if (wr == 1) PG8_BAR;
    PG8_WAIT_V(4); PG8_BAR;
    PG8_STAGE(PG8_SB(1, 0), cB + kstep, voffB); PG8_STAGE(PG8_SA(1, 0), cA + kstep, voffA); PG8_STAGE(PG8_SB(1, 1), cB + hstep + kstep, voffB);
    PG8_WAIT_V(6); PG8_BAR;
    PG8_STAMP();
    for (;;) {
        const bool has_next = S.next(ui + 1, nxt);
        const char* nA = has_next ? (const char*)g.A + (size_t)nxt.pm * tstep : cA; const char* nB = has_next ? (const char*)g.Bt + (size_t)nxt.pn * tstep : cB;
        for (int t = 0; t < nt; t += 2) {
            const bool last = (t == nt - 2);
            const char* a1 = cA + (size_t)(t + 1) * kstep;
            const char* a2 = last ? nA : cA + (size_t)(t + 2) * kstep; const char* b2 = last ? nB : cB + (size_t)(t + 2) * kstep;
            const char* a3 = a2 + kstep; const char* b3 = b2 + kstep;
            if (last && has_next) S.a_ready(nxt);
            PG8_LDB(B0, 0, 0); PG8_SCHED; PG8_LDA(At, 0, 0); PG8_STAGE(PG8_SA(1, 1), a1 + hstep, voffA);
            PG8_WAIT_L(8); PG8_BAR; PG8_WAIT_L(0); PG8_MMA(0, 0, At, B0); PG8_BAR; PG8_SCHED;
            PG8_LDB(B1, 0, 1); PG8_STAGE(PG8_SB(0, 0), b2, voffB);
            PG8_BAR; PG8_WAIT_L(0); PG8_MMA(0, 1, At, B1); PG8_BAR;
            PG8_LDA(At, 0, 1); PG8_STAGE(PG8_SA(0, 0), a2, voffA);
            PG8_BAR; PG8_WAIT_L(0); PG8_MMA(1, 0, At, B0); PG8_BAR; PG8_SCHED;
            PG8_STAGE(PG8_SB(0, 1), b2 + hstep, voffB);
            PG8_WAIT_V(6); PG8_BAR; PG8_MMA(1, 1, At, B1); PG8_BAR;
            PG8_LDB(B0, 1, 0); PG8_SCHED; PG8_LDA(At, 1, 0); PG8_STAGE(PG8_SA(0, 1), a2 + hstep, voffA);
            PG8_WAIT_L(8); PG8_BAR; PG8_WAIT_L(0); PG8_MMA(0, 0, At, B0); PG8_BAR; PG8_SCHED;
            PG8_LDB(B1, 1, 1); PG8_STAGE(PG8_SB(1, 0), b3, voffB);
            PG8_BAR; PG8_WAIT_L(0); PG8_MMA(0, 1, At, B1); PG8_BAR;
            PG8_LDA(At, 1, 1); PG8_STAGE(PG8_SA(1, 0), a3, voffA);
            PG8_BAR; PG8_WAIT_L(0); PG8_MMA(1, 0, At, B0); PG8_BAR; PG8_SCHED;
            PG8_STAGE(PG8_SB(1, 1), b3 + hstep, voffB);
            PG8_WAIT_V(6); PG8_BAR; PG8_MMA(1, 1, At, B1); PG8_BAR;
        }
        PG8_STAMP();
        if constexpr (!Epi::AFTER_DRAIN) { E(acc, cur, wr, wc, fr, fq); S.done(cur); }
        PG8_STAMP();
        if (!has_next) break;
#pragma unroll
        for (int a = 0; a < 2; ++a)
#pragma unroll
            for (int b = 0; b < 2; ++b)
#pragma unroll
                for (int m = 0; m < 4; ++m)
#pragma unroll
                    for (int n = 0; n < 2; ++n) acc[a][b][m][n] = (f32x4){0.f, 0.f, 0.f, 0.f};
        cur = nxt; cA = nA; cB = nB; ++ui;
    }
    PG8_WAIT_V(0);
    if (wr == 0) PG8_BAR;
    PG8_BAR;
    if constexpr (Epi::AFTER_DRAIN) { E.fused(acc, cur, wr, wc, fr, fq, lds, wid, lane); S.done(cur); }
    PG8_STAMP();
    if (STAMP && wid == 0) { stamps[lane] = lane < nts ? (((unsigned long long)(unsigned)ts_hi << 32) | (unsigned)ts_lo) : 0ull;
        if (lane == 62) stamps[62] = rt_entry; if (lane == 63) stamps[63] = (unsigned long long)wall_clock64(); }
#undef PG8_STAMP
#undef PG8_SA
#undef PG8_SB
#undef PG8_STAGE
#undef PG8_LDA
#undef PG8_LDB
#undef PG8_MMA
#undef PG8_WAIT_V
#undef PG8_WAIT_L
#undef PG8_BAR
#undef PG8_SCHED
}
}
#define LAS __attribute__((address_space(3)))
typedef unsigned short bf16;
typedef float f32x4 __attribute__((ext_vector_type(4)));
typedef unsigned u32x4 __attribute__((ext_vector_type(4)));
typedef unsigned u32x2 __attribute__((ext_vector_type(2)));
typedef float f32x2 __attribute__((ext_vector_type(2)));
typedef short bf16x8 __attribute__((ext_vector_type(8)));
constexpr int M = 32768, T = 8192, D = 1024, FF = 2816;
constexpr size_t MiB = 1u << 20;
constexpr size_t WS_LB = 0, WS_SSQ1 = 65536, WS_SSQ2 = 65536 + 131072;
constexpr size_t WS_WTIN = 2 * MiB, WS_WTOUT = 10 * MiB, WS_WT13 = 12 * MiB, WS_WT2 = 23 * MiB, WS_LT = 29 * MiB;
constexpr size_t WS_HG = 32 * MiB, WS_RW = 160 * MiB, WS_Y = 272 * MiB, WS_W = 272 * MiB, WS_KK = 336 * MiB, WS_BB = 368 * MiB, WS_KM = 400 * MiB, WS_R = 432 * MiB, WS_V = 464 * MiB;
constexpr size_t WS_GC = 496 * MiB;
constexpr size_t WS_MIX = 160 * MiB, WS_X1B = 272 * MiB, WS_U = 32 * MiB, WS_END = 500 * MiB;
constexpr size_t WS_CA = 160 * MiB, DO_CB = 32 * MiB, WS_CG = 498 * MiB, WS_OH = 336 * MiB;
constexpr int CA_SZ = 14336, CB_SZ = 12288;
constexpr size_t DO_XN = 0, DO_G = 0;
constexpr int LDS_BYTES = 147456;
constexpr int NPHASE = 10;
#ifndef N_LAUNCHES
#define N_LAUNCHES 1
#endif

__device__ __forceinline__ unsigned f2bf(float f) { unsigned u = __float_as_uint(f); return (u + 0x7fffu + ((u >> 16) & 1u)) >> 16; }
typedef __bf16 bf16x2_t __attribute__((ext_vector_type(2)));
__device__ __forceinline__ unsigned pk2(float lo, float hi) { f32x2 v = {lo, hi}; bf16x2_t b = __builtin_convertvector(v, bf16x2_t); return __builtin_bit_cast(unsigned, b); }
__device__ __forceinline__ float bflo(unsigned u) { return __uint_as_float(u << 16); }
__device__ __forceinline__ float bfhi(unsigned u) { return __uint_as_float(u & 0xffff0000u); }
__device__ __forceinline__ float bf1(bf16 b) { return __uint_as_float(((unsigned)b) << 16); }
__device__ __forceinline__ float sigmf(float v) { return __builtin_amdgcn_rcpf(1.0f + __expf(-v)); }
__device__ __forceinline__ float wave_sum(float v) {
#pragma unroll
    for (int o = 1; o < 64; o <<= 1) v += __shfl_xor(v, o);
    return v;
}
#define BAR_LDS() do { asm volatile("s_waitcnt lgkmcnt(0)" ::: "memory"); __builtin_amdgcn_s_barrier(); asm volatile("" ::: "memory"); } while (0)
template <int CTRL> __device__ __forceinline__ float dpp_add(float v) { return v + __int_as_float(__builtin_amdgcn_update_dpp(0, __float_as_int(v), CTRL, 0xf, 0xf, true)); }
__device__ __forceinline__ float rowsum16(float v) { v = dpp_add<0xB1>(v); v = dpp_add<0x4E>(v); v = dpp_add<0x141>(v); v = dpp_add<0x140>(v); return v; }

#define XB_TMO      128
#define XB_XCNT(j)  (256  + 64 * (j))
#define XB_XSUB(j)  (1280 + 64 * (j))
#define XB_XGEN(j)  (2304 + 64 * (j))
#define XB_TOP      3328
#define XB_TOPGEN   3392
#define XCD_BAR_WORDS 3456
#define XB_SPIN_CAP (1u << 18)

__device__ __forceinline__ unsigned xb_ld(unsigned* p)              { return __hip_atomic_load(p, __ATOMIC_RELAXED, __HIP_MEMORY_SCOPE_AGENT); }
__device__ __forceinline__ unsigned xb_add(unsigned* p, unsigned v) { return __hip_atomic_fetch_add(p, v, __ATOMIC_RELAXED, __HIP_MEMORY_SCOPE_AGENT); }
__device__ __forceinline__ unsigned xb_xcc_id() { return (unsigned)__builtin_amdgcn_s_getreg((3 << 11) | 20) & 0xFu; }
#define XB_SPIN(cond, bar) do { unsigned _sp = 0; while (cond) { __builtin_amdgcn_s_sleep(1); \
    if ((++_sp & 255u) == 0u) { if (xb_ld(&(bar)[XB_TMO])) break; if (_sp > XB_SPIN_CAP) { atomicAdd(&(bar)[XB_TMO], 1u); break; } } } } while (0)

struct XcdBarrier {
    unsigned* bar; unsigned x;
    volatile LAS unsigned* st;
};

__device__ __forceinline__ XcdBarrier xcd_barrier_post(unsigned* bar, volatile LAS unsigned* st) {
    XcdBarrier b; b.bar = bar; b.x = xb_xcc_id(); b.st = st;
    if (threadIdx.x == 0) (void)xb_add(&bar[XB_XCNT(b.x)], 1u);
    return b;
}
__device__ __forceinline__ void xcd_barrier_complete(unsigned* bar, unsigned x, unsigned& nloc, unsigned& nx) {
    const unsigned G = gridDim.x * gridDim.y * gridDim.z;
    unsigned sum, cnt, mine, sp = 0u;
    for (;;) {
        sum = 0u; cnt = 0u; mine = 0u;
#pragma unroll
        for (unsigned j = 0; j < 16; ++j) { const unsigned c = xb_ld(&bar[XB_XCNT(j)]); sum += c; cnt += (c > 0u) ? 1u : 0u; mine = (j == x) ? c : mine; }
        if (sum == G) break;
        __builtin_amdgcn_s_sleep(1);
        if ((++sp & 255u) == 0u) { if (xb_ld(&bar[XB_TMO])) break; if (sp > XB_SPIN_CAP) { atomicAdd(&bar[XB_TMO], 1u); break; } }
    }
    nloc = mine > 0u ? mine : 1u; nx = cnt > 0u ? cnt : 1u;
}

__device__ __forceinline__ void xcd_barrier(const XcdBarrier& b) {
    asm volatile("s_waitcnt vmcnt(0)" ::: "memory");
    __syncthreads();
    if (threadIdx.x == 0) {
        unsigned* bar = b.bar;
        __builtin_amdgcn_s_waitcnt(0);
        unsigned nloc = b.st[0], nx = b.st[1];
        if (nloc == 0u) { xcd_barrier_complete(bar, b.x, nloc, nx); b.st[0] = nloc; b.st[1] = nx; }
        const unsigned old = xb_add(&bar[XB_XSUB(b.x)], 1u);
        const unsigned gen = old / nloc;
        if (old + 1u == (gen + 1u) * nloc) {
            __builtin_amdgcn_fence(__ATOMIC_RELEASE, "agent");
            asm volatile("s_waitcnt vmcnt(0)" ::: "memory");
            const unsigned og = xb_add(&bar[XB_TOP], 1u);
            const unsigned tg = og / nx;
            if (og + 1u == (tg + 1u) * nx) xb_add(&bar[XB_TOPGEN], 1u);
            else XB_SPIN(xb_ld(&bar[XB_TOPGEN]) == tg, bar);
            __builtin_amdgcn_fence(__ATOMIC_ACQUIRE, "agent");
            xb_add(&bar[XB_XGEN(b.x)], 1u);
            asm volatile("s_waitcnt vmcnt(0)" ::: "memory");
        } else {
            XB_SPIN(xb_ld(&bar[XB_XGEN(b.x)]) == gen, bar);
            __builtin_amdgcn_fence(__ATOMIC_ACQUIRE, "agent");
            asm volatile("s_waitcnt vmcnt(0)" ::: "memory");
        }
    }
    __syncthreads();
}

constexpr size_t WS_BAR = 524288;
struct Args { const float* in[22]; float* out; unsigned char* ws; int ph_lo, ph_hi; };

__device__ __forceinline__ void p0_transpose_item(const float* W, int K, int N, bf16* WT, int ld, int koff, int mode, LAS float* scr, int item, int lane) {
    const int nblk = N / 32, kb = item / nblk, nb = item % nblk, k0 = 64 * kb, n0 = 32 * nb;
#pragma unroll 8
    for (int i = 0; i < 32; ++i) { const int kk = 2 * i + (lane >> 5); scr[kk * 33 + (lane & 31)] = W[(size_t)(k0 + kk) * N + n0 + (lane & 31)]; }
    asm volatile("s_waitcnt lgkmcnt(0)" ::: "memory");
    const int c = lane & 7;
#pragma unroll
    for (int j = 0; j < 4; ++j) { const int n = (lane >> 3) + 8 * j; const LAS float* s = scr + (8 * c) * 33 + n;
        u32x4 o; o.x = pk2(s[0 * 33], s[1 * 33]); o.y = pk2(s[2 * 33], s[3 * 33]); o.z = pk2(s[4 * 33], s[5 * 33]); o.w = pk2(s[6 * 33], s[7 * 33]);
        const int ng = n0 + n, row = mode == 0 ? ng : ((ng >> 2) * 8 + (ng & 3) + (mode == 2 ? 4 : 0));
        *(u32x4*)(WT + (size_t)row * ld + koff + k0 + 8 * c) = o; }
    asm volatile("s_waitcnt lgkmcnt(0)" ::: "memory");
}
__device__ __forceinline__ void phase0(const Args& a, LAS unsigned char* lds) {
    const int tid = threadIdx.x, lane = tid & 63, wave = tid >> 6, gw = blockIdx.x * 8 + wave, NGW = gridDim.x * 8;
    unsigned char* ws = a.ws;
    LAS float* scr = (LAS float*)(lds + wave * 16384);
    constexpr int I_IN = 16 * 120, I_OUT = 16 * 32, I_1 = 16 * 88, I_2 = 44 * 32, I_L = 16, I_G = 32;
    constexpr int NITEMS = I_IN + I_OUT + 2 * I_1 + I_2 + 2 * I_L + I_G;
    for (int it = gw; it < NITEMS; it += NGW) {
        int r = it;
        if (r < I_IN) { p0_transpose_item(a.in[2], 1024, 3840, (bf16*)(ws + WS_WTIN), 1024, 0, 0, scr, r, lane); continue; } r -= I_IN;
        if (r < I_OUT) { p0_transpose_item(a.in[16], 1024, 1024, (bf16*)(ws + WS_WTOUT), 1024, 0, 0, scr, r, lane); continue; } r -= I_OUT;
        if (r < I_1) { p0_transpose_item(a.in[18], 1024, 2816, (bf16*)(ws + WS_WT13), 1024, 0, 1, scr, r, lane); continue; } r -= I_1;
        if (r < I_1) { p0_transpose_item(a.in[19], 1024, 2816, (bf16*)(ws + WS_WT13), 1024, 0, 2, scr, r, lane); continue; } r -= I_1;
        if (r < I_2) { p0_transpose_item(a.in[20], 2816, 1024, (bf16*)(ws + WS_WT2), 2816, 0, 0, scr, r, lane); continue; } r -= I_2;
        if (r < I_L) { p0_transpose_item(a.in[7], 64, 512, (bf16*)(ws + WS_LT), 256, 0, 0, scr, r, lane); continue; } r -= I_L;
        if (r < I_L) { p0_transpose_item(a.in[9], 64, 512, (bf16*)(ws + WS_LT), 256, 64, 0, scr, r, lane); continue; } r -= I_L;
        p0_transpose_item(a.in[10], 128, 512, (bf16*)(ws + WS_LT), 256, 128, 0, scr, r, lane);
    }
    const float* x = a.in[0]; const float* nw = a.in[1]; bf16* XN = (bf16*)((unsigned char*)a.out + DO_XN);
    f32x4 wv[4];
#pragma unroll
    for (int j = 0; j < 4; ++j) wv[j] = *((const f32x4*)nw + 64 * j + lane);
    for (int m = gw; m < M; m += NGW) {
        const f32x4* xr = (const f32x4*)(x + (size_t)m * D) + lane;
        f32x4 v[4]; float s = 0.f;
#pragma unroll
        for (int j = 0; j < 4; ++j) { v[j] = xr[64 * j]; s += (v[j].x * v[j].x + v[j].y * v[j].y) + (v[j].z * v[j].z + v[j].w * v[j].w); }
        const float rstd = __builtin_amdgcn_rsqf(wave_sum(s) * (1.f / D) + 1e-6f);
        u32x2* o8 = (u32x2*)(XN + (size_t)m * D) + lane;
#pragma unroll
        for (int j = 0; j < 4; ++j) { u32x2 o; o.x = pk2(v[j].x * rstd * wv[j].x, v[j].y * rstd * wv[j].y); o.y = pk2(v[j].z * rstd * wv[j].z, v[j].w * rstd * wv[j].w); o8[64 * j] = o; }
    }
    const int gt = blockIdx.x * 512 + tid, NGT = gridDim.x * 512;
    if (gt < 512) { const float* hb = a.in[3]; ((float*)(ws + WS_LB))[gt] = 1.0f / (1.0f + __expf(hb[512 + gt] - hb[gt])); }
    for (int i = gt; i < 2 * M; i += NGT) ((float*)(ws + WS_SSQ1))[i] = 0.f;
}

constexpr int ALD = 264;
__device__ __forceinline__ void phase2(const Args& a, LAS unsigned char* lds) {
    const int tid = threadIdx.x, lane = tid & 63, wave = tid >> 6, tok = lane & 15, q = lane >> 4;
    unsigned char* ws = a.ws;
    const bf16* __restrict__ RW = (const bf16*)(ws + WS_RW); const bf16* __restrict__ LT = (const bf16*)(ws + WS_LT);
    const float* __restrict__ mix = a.in[5]; const float* __restrict__ w0 = a.in[6]; const float* __restrict__ a0 = a.in[8]; const float* __restrict__ k_k = a.in[11]; const float* __restrict__ k_a = a.in[12];
    float* __restrict__ Wd = (float*)(ws + WS_W); bf16* __restrict__ KK = (bf16*)(ws + WS_KK); bf16* __restrict__ BB = (bf16*)(ws + WS_BB); bf16* __restrict__ KM = (bf16*)(ws + WS_KM); bf16* __restrict__ R = (bf16*)(ws + WS_R); bf16* __restrict__ V = (bf16*)(ws + WS_V);
    bf16* __restrict__ G = (bf16*)((unsigned char*)a.out + DO_G);
    LAS bf16* A = (LAS bf16*)lds;
    for (int item = blockIdx.x; item < M / 64; item += gridDim.x) {
        const int row0 = item * 64;
        __syncthreads();
#pragma unroll
        for (int i = 0; i < 4; ++i) {
            const int vi = tid + 512 * i, t = vi >> 5, cg8 = vi & 31, row = row0 + t, col = 1536 + 8 * cg8;
            const u32x4 p = *(const u32x4*)(RW + (size_t)row * 1792 + col);
            u32x4 pp = (u32x4){0u, 0u, 0u, 0u};
            if ((row & (T - 1)) != 0) pp = *(const u32x4*)(RW + (size_t)(row - 1) * 1792 + col);
            const f32x4 m0 = *(const f32x4*)(mix + col), m1 = *(const f32x4*)(mix + col + 4);
            float f[8];
            f[0] = bflo(p.x) + (bflo(pp.x) - bflo(p.x)) * m0.x; f[1] = bfhi(p.x) + (bfhi(pp.x) - bfhi(p.x)) * m0.y;
            f[2] = bflo(p.y) + (bflo(pp.y) - bflo(p.y)) * m0.z; f[3] = bfhi(p.y) + (bfhi(pp.y) - bfhi(p.y)) * m0.w;
            f[4] = bflo(p.z) + (bflo(pp.z) - bflo(p.z)) * m1.x; f[5] = bfhi(p.z) + (bfhi(pp.z) - bfhi(p.z)) * m1.y;
            f[6] = bflo(p.w) + (bflo(pp.w) - bflo(p.w)) * m1.z; f[7] = bfhi(p.w) + (bfhi(pp.w) - bfhi(p.w)) * m1.w;
            if (cg8 < 8) {
#pragma unroll
                for (int j = 0; j < 8; ++j) f[j] = 1.0f - 2.0f * __builtin_amdgcn_rcpf(1.0f + __expf(2.0f * f[j]));
            } else if (cg8 >= 16) {
#pragma unroll
                for (int j = 0; j < 8; ++j) f[j] = sigmf(f[j]);
            }
            u32x4 o; o.x = pk2(f[0], f[1]); o.y = pk2(f[2], f[3]); o.z = pk2(f[4], f[5]); o.w = pk2(f[6], f[7]);
            *(LAS u32x4*)(A + t * ALD + 8 * cg8) = o;
        }
        __syncthreads();
        for (int mt = 0; mt < 4; ++mt) {
            f32x4 aw[4], aa[4], ag[4];
#pragma unroll
            for (int nt = 0; nt < 4; ++nt) { aw[nt] = (f32x4){0.f, 0.f, 0.f, 0.f}; aa[nt] = aw[nt]; ag[nt] = aw[nt]; }
            bf16x8 xf[8];
#pragma unroll
            for (int ks = 0; ks < 8; ++ks) xf[ks] = *(const LAS bf16x8*)(A + (16 * mt + tok) * ALD + 32 * ks + 8 * q);
#pragma unroll
            for (int nt = 0; nt < 4; ++nt) {
                const bf16* lrow = LT + (size_t)(64 * wave + 16 * (tok >> 2) + 4 * nt + (tok & 3)) * 256 + 8 * q;
#pragma unroll
                for (int ks = 0; ks < 8; ++ks) {
                    const bf16x8 wf = *(const bf16x8*)(lrow + 32 * ks);
                    if (ks < 2) aw[nt] = __builtin_amdgcn_mfma_f32_16x16x32_bf16(wf, xf[ks], aw[nt], 0, 0, 0);
                    else if (ks < 4) aa[nt] = __builtin_amdgcn_mfma_f32_16x16x32_bf16(wf, xf[ks], aa[nt], 0, 0, 0);
                    else ag[nt] = __builtin_amdgcn_mfma_f32_16x16x32_bf16(wf, xf[ks], ag[nt], 0, 0, 0);
                }
            }
            const int row = row0 + 16 * mt + tok; const bool hasprev = (row & (T - 1)) != 0;
            const bf16* pr = RW + (size_t)row * 1792; const bf16* ppr = pr - 1792;
            float kkv[4][4], av[4][4]; float ss = 0.f;
#pragma unroll
            for (int nt = 0; nt < 4; ++nt) {
                const int c = 64 * wave + 16 * q + 4 * nt;
                float rr[4], kk[4], vv[4];
#pragma unroll
                for (int part = 0; part < 3; ++part) {
                    const u32x2 p = *(const u32x2*)(pr + 512 * part + c); u32x2 pp = (u32x2){0u, 0u};
                    if (hasprev) pp = *(const u32x2*)(ppr + 512 * part + c);
                    const f32x4 mx = *(const f32x4*)(mix + 512 * part + c);
                    float* dst = part == 0 ? rr : (part == 1 ? kk : vv);
                    dst[0] = bflo(p.x) + (bflo(pp.x) - bflo(p.x)) * mx.x; dst[1] = bfhi(p.x) + (bfhi(pp.x) - bfhi(p.x)) * mx.y;
                    dst[2] = bflo(p.y) + (bflo(pp.y) - bflo(p.y)) * mx.z; dst[3] = bfhi(p.y) + (bfhi(pp.y) - bfhi(p.y)) * mx.w;
                }
                const f32x4 w0v = *(const f32x4*)(w0 + c), a0v = *(const f32x4*)(a0 + c), kkw = *(const f32x4*)(k_k + c), kaw = *(const f32x4*)(k_a + c);
                f32x4 dec; float km[4];
#pragma unroll
                for (int j = 0; j < 4; ++j) {
                    const float z = -(w0v[j] + aw[nt][j]);
                    const float sp = fmaxf(z, 0.f) + __logf(1.0f + __expf(-fabsf(z)));
                    dec[j] = -__expf(-sp - 0.5f);
                    const float al = sigmf(a0v[j] + aa[nt][j]);
                    av[nt][j] = al;
                    kkv[nt][j] = kk[j] * kkw[j]; ss += kkv[nt][j] * kkv[nt][j];
                    km[j] = kk[j] * (1.0f + (al - 1.0f) * kaw[j]);
                }
                const size_t o = (size_t)row * 512 + c;
                *(f32x4*)(Wd + o) = dec;
                u32x2 t2; t2.x = pk2(rr[0], rr[1]); t2.y = pk2(rr[2], rr[3]); *(u32x2*)(R + o) = t2;
                t2.x = pk2(km[0], km[1]); t2.y = pk2(km[2], km[3]); *(u32x2*)(KM + o) = t2;
                t2.x = pk2(vv[0], vv[1]); t2.y = pk2(vv[2], vv[3]); *(u32x2*)(V + o) = t2;
                t2.x = pk2(ag[nt][0], ag[nt][1]); t2.y = pk2(ag[nt][2], ag[nt][3]); *(u32x2*)(G + o) = t2;
            }
            ss += __shfl_xor(ss, 16); ss += __shfl_xor(ss, 32);
            const float inv = 1.0f / fmaxf(sqrtf(ss), 1e-12f);
#pragma unroll
            for (int nt = 0; nt < 4; ++nt) {
                const size_t o = (size_t)row * 512 + 64 * wave + 16 * q + 4 * nt;
                float kn[4];
#pragma unroll
                for (int j = 0; j < 4; ++j) kn[j] = kkv[nt][j] * inv;
                u32x2 t2; t2.x = pk2(kn[0], kn[1]); t2.y = pk2(kn[2], kn[3]); *(u32x2*)(KK + o) = t2;
                t2.x = pk2(-kn[0] * av[nt][0], -kn[1] * av[nt][1]); t2.y = pk2(-kn[2] * av[nt][2], -kn[3] * av[nt][3]); *(u32x2*)(BB + o) = t2;
            }
        }
    }
}
__device__ __forceinline__ void rwkv_scan(const Args& a, LAS unsigned char* lds, int bh, int sl) {
    const int tid = threadIdx.x; unsigned char* ws = a.ws;
    const int b = bh >> 3, h = bh & 7; const size_t m0 = (size_t)b * T; const int c0 = 64 * h;
    const float* Wd = (const float*)(ws + WS_W); const bf16* KK = (const bf16*)(ws + WS_KK); const bf16* BB = (const bf16*)(ws + WS_BB);
    const bf16* KM = (const bf16*)(ws + WS_KM); const bf16* R = (const bf16*)(ws + WS_R); const bf16* V = (const bf16*)(ws + WS_V);
    float* Y = (float*)(ws + WS_Y);
    constexpr int BUF = 5 * 16 * 64 * 4 + 16 * 16 * 4;
    constexpr int NT = T / 16;
    if (tid >= 256) {
        const int lt = tid - 256, st = lt >> 4, l16 = lt & 15, c4 = 4 * l16;
        f32x4 w; u32x2 kk, bb, km, r; bf16 v;
#define RW_LOAD(tile) do { const size_t row = m0 + (size_t)(tile) * 16 + st; const size_t o = row * 512 + c0 + c4; \
        w = *(const f32x4*)(Wd + o); kk = *(const u32x2*)(KK + o); bb = *(const u32x2*)(BB + o); km = *(const u32x2*)(KM + o); r = *(const u32x2*)(R + o); v = V[row * 512 + c0 + 16 * sl + l16]; } while (0)
#define RW_STORE(bufi) do { LAS float* B = (LAS float*)(lds + (bufi) * BUF); const int o = st * 64 + c4; \
        *(LAS f32x4*)(B + o) = w; \
        *(LAS f32x4*)(B + 1024 + o) = (f32x4){bflo(kk.x), bfhi(kk.x), bflo(kk.y), bfhi(kk.y)}; \
        *(LAS f32x4*)(B + 2048 + o) = (f32x4){bflo(bb.x), bfhi(bb.x), bflo(bb.y), bfhi(bb.y)}; \
        *(LAS f32x4*)(B + 3072 + o) = (f32x4){bflo(km.x), bfhi(km.x), bflo(km.y), bfhi(km.y)}; \
        *(LAS f32x4*)(B + 4096 + o) = (f32x4){bflo(r.x), bfhi(r.x), bflo(r.y), bfhi(r.y)}; \
        B[5120 + st * 16 + l16] = bf1(v); } while (0)
        RW_LOAD(0); RW_STORE(0); RW_LOAD(1);
        __syncthreads();
        for (int it = 0; it < NT; ++it) {
            if (it + 1 < NT) RW_STORE((it + 1) & 1);
            if (it + 2 < NT) RW_LOAD(it + 2);
            __syncthreads();
        }
#undef RW_LOAD
#undef RW_STORE
    } else {
        const int wv = tid >> 6, l = tid & 63, rloc = 4 * wv + (l >> 4), kq = l & 15;
        f32x2 S01 = (f32x2){0.f, 0.f}, S23 = S01;
        float* yrow = Y + ((size_t)bh * 64 + 16 * sl + rloc) * T + kq;
        __syncthreads();
        for (int it = 0; it < NT; ++it) {
            const LAS float* B = (const LAS float*)(lds + (it & 1) * BUF);
            float ysel = 0.f;
#pragma unroll 4
            for (int st = 0; st < 16; ++st) {
                const int o = st * 64 + 4 * kq;
                const f32x4 w = *(const LAS f32x4*)(B + o), kk = *(const LAS f32x4*)(B + 1024 + o), bn = *(const LAS f32x4*)(B + 2048 + o), km = *(const LAS f32x4*)(B + 3072 + o), r = *(const LAS f32x4*)(B + 4096 + o);
                const float vv = B[5120 + st * 16 + rloc];
                const f32x2 p2 = S01 * kk.lo + S23 * kk.hi;
                const float sa = rowsum16(p2.x + p2.y);
                const f32x2 sa2 = (f32x2){sa, sa}, vv2 = (f32x2){vv, vv};
                S01 = S01 * w.lo + (sa2 * bn.lo + vv2 * km.lo);
                S23 = S23 * w.hi + (sa2 * bn.hi + vv2 * km.hi);
                const f32x2 y2 = S01 * r.lo + S23 * r.hi;
                const float y = rowsum16(y2.x + y2.y);
                ysel = (kq == st) ? y : ysel;
            }
            yrow[it * 16] = ysel;
            __syncthreads();
        }
    }
}
__device__ __forceinline__ void hgrn_scan(const Args& a, LAS unsigned char* lds, int bh, int sl) {
    const int tid = threadIdx.x; unsigned char* ws = a.ws;
    const int b = bh >> 2, h = bh & 3; const size_t m0 = (size_t)b * T;
    const bf16* HG = (const bf16*)(ws + WS_HG);
    float* OH = (float*)(a.ws + WS_OH);
    constexpr int BUF = 2 * 16 * 128 * 4 + 16 * 16 * 4;
    constexpr int NT = T / 16;
    if (tid >= 256) {
        const int lt = tid - 256, st = lt >> 4, l16 = lt & 15, c8 = 8 * l16;
        u32x4 f, q; bf16 iv;
#define HG_LOAD(tile) do { const bf16* rp = HG + (m0 + (size_t)(tile) * 16 + st) * 2048 + 128 * h; \
        q = *(const u32x4*)(rp + c8); f = *(const u32x4*)(rp + 512 + c8); iv = rp[1024 + 16 * sl + l16]; } while (0)
#define HG_STORE(bufi) do { LAS float* B = (LAS float*)(lds + (bufi) * BUF); const int o = st * 128 + c8; \
        *(LAS f32x4*)(B + o) = (f32x4){bflo(f.x), bfhi(f.x), bflo(f.y), bfhi(f.y)}; *(LAS f32x4*)(B + o + 4) = (f32x4){bflo(f.z), bfhi(f.z), bflo(f.w), bfhi(f.w)}; \
        *(LAS f32x4*)(B + 2048 + o) = (f32x4){bflo(q.x), bfhi(q.x), bflo(q.y), bfhi(q.y)}; *(LAS f32x4*)(B + 2048 + o + 4) = (f32x4){bflo(q.z), bfhi(q.z), bflo(q.w), bfhi(q.w)}; \
        B[4096 + st * 16 + l16] = bf1(iv); } while (0)
        HG_LOAD(0); HG_STORE(0); HG_LOAD(1);
        __syncthreads();
        for (int it = 0; it < NT; ++it) {
            if (it + 1 < NT) HG_STORE((it + 1) & 1);
            if (it + 2 < NT) HG_LOAD(it + 2);
            __syncthreads();
        }
#undef HG_LOAD
#undef HG_STORE
    } else {
        const int wv = tid >> 6, l = tid & 63, rloc = 4 * wv + (l >> 4), kq = l & 15;
        f32x2 S0 = (f32x2){0.f, 0.f}, S1 = S0, S2 = S0, S3 = S0;
        float* orow = OH + ((size_t)bh * 128 + 16 * sl + rloc) * T + kq;
        __syncthreads();
        for (int it = 0; it < NT; ++it) {
            const LAS float* B = (const LAS float*)(lds + (it & 1) * BUF);
            float osel = 0.f;
#pragma unroll 4
            for (int st = 0; st < 16; ++st) {
                const int o = st * 128 + 4 * kq;
                const f32x4 f0 = *(const LAS f32x4*)(B + o), f1 = *(const LAS f32x4*)(B + o + 64), q0 = *(const LAS f32x4*)(B + 2048 + o), q1 = *(const LAS f32x4*)(B + 2048 + o + 64);
                const float iv = B[4096 + st * 16 + rloc];
                const f32x2 iv2 = (f32x2){iv, iv};
                S0 = f0.lo * (S0 - iv2) + iv2; S1 = f0.hi * (S1 - iv2) + iv2; S2 = f1.lo * (S2 - iv2) + iv2; S3 = f1.hi * (S3 - iv2) + iv2;
                const f32x2 p2 = (S0 * q0.lo + S1 * q0.hi) + (S2 * q1.lo + S3 * q1.hi);
                const float p = rowsum16(p2.x + p2.y);
                osel = (kq == st) ? p : osel;
            }
            orow[it * 16] = osel;
            __syncthreads();
        }
    }
}

__device__ __forceinline__ void phase2h(const Args& a) {
    const int tid = threadIdx.x, half = tid >> 8, cp = tid & 255;
    bf16* __restrict__ HG = (bf16*)(a.ws + WS_HG); float* __restrict__ GC = (float*)(a.ws + WS_GC);
    for (int rc = blockIdx.x * 2 + half; rc < M / 32; rc += gridDim.x * 2) {
        bf16* p = HG + (size_t)rc * 32 * 2048 + 2 * cp;
        float g0 = 0.f, g1 = 0.f;
#pragma unroll 8
        for (int t = 0; t < 32; ++t) {
            const unsigned q2 = *(const unsigned*)(p + (size_t)t * 2048), f2 = *(const unsigned*)(p + (size_t)t * 2048 + 512);
            const float f0 = bflo(f2), f1 = bfhi(f2);
            g0 += __logf(f0); g1 += __logf(f1);
            const float e0 = __expf(g0), e1 = __expf(g1);
            *(unsigned*)(p + (size_t)t * 2048) = pk2(bflo(q2) * e0, bfhi(q2) * e1);
            *(unsigned*)(p + (size_t)t * 2048 + 512) = pk2((1.0f - f0) * __builtin_amdgcn_rcpf(e0), (1.0f - f1) * __builtin_amdgcn_rcpf(e1));
        }
        typedef float f32x2_ __attribute__((ext_vector_type(2)));
        *(f32x2_*)(GC + (size_t)rc * 512 + 2 * cp) = (f32x2_){__expf(g0), __expf(g1)};
    }
}

__device__ __forceinline__ bf16x8 ldfrag(const LAS bf16* base, int pitch, int lane) { return *(const LAS bf16x8*)(base + (lane & 15) * pitch + 8 * (lane >> 4)); }
__device__ __forceinline__ void hgrn_seq(const Args& a, LAS unsigned char* lds, int bh, int vh) {
    const int tid = threadIdx.x, lane = tid & 63, w = tid >> 6, q = lane >> 4, r16 = lane & 15;
    const int b = bh >> 2, h = bh & 3; const size_t m0 = (size_t)b * T;
    const bf16* __restrict__ HG = (const bf16*)(a.ws + WS_HG); const float* __restrict__ GC = (const float*)(a.ws + WS_GC);
    float* __restrict__ OH = (float*)(a.ws + WS_OH);
    LAS bf16* Qs = (LAS bf16*)lds; LAS bf16* Ks = Qs + 4352; LAS bf16* KT = Ks + 4352; LAS bf16* VT = KT + 5120; LAS bf16* Am = VT + 2 * 2560; LAS bf16* ST = Am + 1280;
    const int lrow = tid >> 4, c8 = (tid & 15) * 8;
    const bool vmine = (c8 >> 6) == vh; const int vloc = c8 & 63;
    const int swz = 8 * ((lrow >> 3) ^ ((tid & 15) & 3)) + (lrow & 7);
#define HS_SCAT2(dst, v) do { (dst)[0 * 40] = (bf16)((v).x & 0xffffu); (dst)[1 * 40] = (bf16)((v).x >> 16); (dst)[2 * 40] = (bf16)((v).y & 0xffffu); (dst)[3 * 40] = (bf16)((v).y >> 16); \
        (dst)[4 * 40] = (bf16)((v).z & 0xffffu); (dst)[5 * 40] = (bf16)((v).z >> 16); (dst)[6 * 40] = (bf16)((v).w & 0xffffu); (dst)[7 * 40] = (bf16)((v).w >> 16); } while (0)
#define LDSW(base, tile) (*(const LAS bf16x8*)((base) + (16 * (tile) + r16) * 40 + 8 * (q ^ ((2 * (tile) + (r16 >> 3)) & 3))))
    struct HOps { u32x4 gq, gk, gv; f32x4 gam; };
    HOps o0, o1, o2, o3;
#define HS_LOADG(O, n) do { const bf16* rp = HG + (m0 + (size_t)(n) * 32 + lrow) * 2048 + 128 * h + c8; (O).gq = *(const u32x4*)rp; (O).gk = *(const u32x4*)(rp + 512); if (vmine) (O).gv = *(const u32x4*)(rp + 1024); \
        (O).gam = *(const f32x4*)(GC + ((size_t)b * 256 + (n)) * 512 + 128 * h + 16 * w + 4 * q); } while (0)
#define HS_STOREL(O, n) do { *(LAS u32x4*)(Qs + lrow * 136 + c8) = (O).gq; *(LAS u32x4*)(Ks + lrow * 136 + c8) = (O).gk; \
        LAS bf16* kt = KT + c8 * 40 + swz; HS_SCAT2(kt, (O).gk); if (vmine) { LAS bf16* vt = VT + ((n) & 1) * 2560 + vloc * 40 + swz; HS_SCAT2(vt, (O).gv); } } while (0)
    f32x4 S[4];
#pragma unroll
    for (int nt = 0; nt < 4; ++nt) S[nt] = (f32x4){0.f, 0.f, 0.f, 0.f};
    for (int i = tid; i < 8704 / 8; i += 512) *(LAS u32x4*)(ST + 8 * i) = (u32x4){0u, 0u, 0u, 0u};
    o0.gv = (u32x4){0u, 0u, 0u, 0u}; o1.gv = o0.gv; o2.gv = o0.gv; o3.gv = o0.gv;
    HS_LOADG(o0, 0); HS_LOADG(o1, 1); HS_LOADG(o2, 2); HS_LOADG(o3, 3); HS_STOREL(o0, 0);
    BAR_LDS();
    const int omt = w >> 2, ont = w & 3;
#define HS_BODY(C, NX, n) do { \
        const LAS bf16* VTc = VT + ((n) & 1) * 2560; \
        if (w < 4) { \
            const int mt = w >> 1, nt = w & 1; f32x4 acc = (f32x4){0.f, 0.f, 0.f, 0.f}; \
            _Pragma("unroll") for (int ks = 0; ks < 4; ++ks) acc = __builtin_amdgcn_mfma_f32_16x16x32_bf16(ldfrag(Qs + 16 * mt * 136 + 32 * ks, 136, lane), ldfrag(Ks + 16 * nt * 136 + 32 * ks, 136, lane), acc, 0, 0, 0); \
            _Pragma("unroll") for (int i = 0; i < 4; ++i) { const int t = 16 * mt + 4 * q + i, sidx = 16 * nt + r16; Am[t * 40 + sidx] = (bf16)f2bf(sidx <= t ? acc[i] : 0.f); } \
        } \
        f32x4 hk[4]; \
        { const bf16x8 kf = LDSW(KT, w); \
          _Pragma("unroll") for (int nt = 0; nt < 4; ++nt) hk[nt] = __builtin_amdgcn_mfma_f32_16x16x32_bf16(kf, LDSW(VTc, nt), (f32x4){0.f, 0.f, 0.f, 0.f}, 0, 0, 0); } \
        f32x4 oa = (f32x4){0.f, 0.f, 0.f, 0.f}; \
        _Pragma("unroll") for (int ks = 0; ks < 4; ++ks) \
            oa = __builtin_amdgcn_mfma_f32_16x16x32_bf16(ldfrag(Qs + 16 * omt * 136 + 32 * ks, 136, lane), ldfrag(ST + 16 * ont * 136 + 32 * ks, 136, lane), oa, 0, 0, 0); \
        BAR_LDS(); \
        oa = __builtin_amdgcn_mfma_f32_16x16x32_bf16(ldfrag(Am + 16 * omt * 40, 40, lane), LDSW(VTc, ont), oa, 0, 0, 0); \
        *(f32x4*)(OH + (((size_t)bh * 256 + (n)) * 128 + 64 * vh + 16 * ont + r16) * 32 + 16 * omt + 4 * q) = oa; \
        _Pragma("unroll") for (int nt = 0; nt < 4; ++nt) { \
            S[nt] = (C).gam * (S[nt] + hk[nt]); \
            u32x2 t2; t2.x = pk2(S[nt][0], S[nt][1]); t2.y = pk2(S[nt][2], S[nt][3]); \
            *(LAS u32x2*)(ST + (16 * nt + r16) * 136 + 16 * w + 4 * q) = t2; } \
        HS_STOREL(NX, (n) + 1); \
        HS_LOADG(C, ((n) + 4 < T / 32 ? (n) + 4 : T / 32 - 1)); \
        BAR_LDS(); } while (0)
    for (int n = 0; n < T / 32; n += 4) { HS_BODY(o0, o1, n); HS_BODY(o1, o2, n + 1); HS_BODY(o2, o3, n + 2); HS_BODY(o3, o0, n + 3); }
#undef HS_BODY
#undef HS_SCAT2
#undef LDSW
#undef HS_LOADG
#undef HS_STOREL
}

__device__ __forceinline__ void phase2c(const Args& a, LAS unsigned char* lds) {
    const int tid = threadIdx.x, lane = tid & 63, w = tid >> 6, q = lane >> 4, r16 = lane & 15;
    unsigned char* ws = a.ws;
    const float* __restrict__ LW = (const float*)(ws + WS_W); const bf16* __restrict__ KK = (const bf16*)(ws + WS_KK); const bf16* __restrict__ BB = (const bf16*)(ws + WS_BB);
    const bf16* __restrict__ KM = (const bf16*)(ws + WS_KM); const bf16* __restrict__ R = (const bf16*)(ws + WS_R); const bf16* __restrict__ V = (const bf16*)(ws + WS_V);
    unsigned char* __restrict__ CA = ws + WS_CA; unsigned char* __restrict__ CB = (unsigned char*)a.out + DO_CB; float* __restrict__ CG = (float*)(ws + WS_CG);
    LAS float* Gs = (LAS float*)lds; LAS float* Lm = Gs + 2048;
    LAS bf16* At = (LAS bf16*)(Lm + 32 * 36); LAS bf16* Rt = At + 2304; LAS bf16* Bt_ = Rt + 2304; LAS bf16* Kt_ = Bt_ + 2304;
    LAS bf16* AT = Kt_ + 2304; LAS bf16* VT = AT + 2560; LAS bf16* KhT = VT + 2560; LAS bf16* AKT = KhT + 2560; LAS bf16* TI = AKT + 1280;
    const int t = tid >> 4, c4 = 4 * (tid & 15);
    for (int it = blockIdx.x; it < 8192; it += gridDim.x) {
        const int bh = it & 31, n = it >> 5, b = bh >> 3, h = bh & 7;
        const size_t o = ((size_t)b * T + 32 * n + t) * 512 + 64 * h + c4;
        const f32x4 lw4 = *(const f32x4*)(LW + o);
        const u32x2 kk2 = *(const u32x2*)(KK + o), bb2 = *(const u32x2*)(BB + o), km2 = *(const u32x2*)(KM + o), r2 = *(const u32x2*)(R + o), v2 = *(const u32x2*)(V + o);
        unsigned char* ca = CA + (size_t)it * CA_SZ; unsigned char* cb = CB + (size_t)it * CB_SZ;
        *(LAS f32x4*)(Gs + t * 64 + c4) = lw4;
        BAR_LDS();
        if (tid < 64) { float g = 0.f;
#pragma unroll 8
            for (int tt = 0; tt < 32; ++tt) { g += Gs[tt * 64 + tid]; Gs[tt * 64 + tid] = g; } }
        BAR_LDS();
        {
            const f32x4 g4 = *(const LAS f32x4*)(Gs + t * 64 + c4), gl4 = *(const LAS f32x4*)(Gs + 31 * 64 + c4);
            f32x4 gp4 = (f32x4){0.f, 0.f, 0.f, 0.f}; if (t > 0) gp4 = *(const LAS f32x4*)(Gs + (t - 1) * 64 + c4);
            const float kkf[4] = {bflo(kk2.x), bfhi(kk2.x), bflo(kk2.y), bfhi(kk2.y)}, bbf[4] = {bflo(bb2.x), bfhi(bb2.x), bflo(bb2.y), bfhi(bb2.y)};
            const float kmf[4] = {bflo(km2.x), bfhi(km2.x), bflo(km2.y), bfhi(km2.y)}, rf[4] = {bflo(r2.x), bfhi(r2.x), bflo(r2.y), bfhi(r2.y)};
            float va[4], vr[4], vb[4], vk[4], vbh[4], vkh[4];
#pragma unroll
            for (int j = 0; j < 4; ++j) {
                const float ea = __expf(gp4[j]), eg = __expf(g4[j]), en = __expf(-g4[j]), el = __expf(gl4[j] - g4[j]);
                va[j] = -kkf[j] * ea; vr[j] = rf[j] * eg; vb[j] = -bbf[j] * en; vk[j] = kmf[j] * en; vbh[j] = -bbf[j] * el; vkh[j] = kmf[j] * el;
            }
            u32x2 p; p.x = pk2(va[0], va[1]); p.y = pk2(va[2], va[3]); *(LAS u32x2*)(At + t * 72 + c4) = p;
            p.x = pk2(vr[0], vr[1]); p.y = pk2(vr[2], vr[3]); *(LAS u32x2*)(Rt + t * 72 + c4) = p; *(u32x2*)(ca + 4096 + (t * 64 + c4) * 2) = p;
            p.x = pk2(vb[0], vb[1]); p.y = pk2(vb[2], vb[3]); *(LAS u32x2*)(Bt_ + t * 72 + c4) = p;
            p.x = pk2(vk[0], vk[1]); p.y = pk2(vk[2], vk[3]); *(LAS u32x2*)(Kt_ + t * 72 + c4) = p;
            bf16* bht = (bf16*)(ca + 8192);
            const unsigned vraw[4] = {v2.x & 0xffffu, v2.x >> 16, v2.y & 0xffffu, v2.y >> 16};
#pragma unroll
            for (int j = 0; j < 4; ++j) {
                AT[(c4 + j) * 40 + t] = (bf16)f2bf(va[j]); VT[(c4 + j) * 40 + t] = (bf16)vraw[j]; KhT[(c4 + j) * 40 + t] = (bf16)f2bf(vkh[j]);
                bht[(c4 + j) * 32 + t] = (bf16)f2bf(vbh[j]);
            }
            if (t == 31) *(f32x4*)(CG + (size_t)it * 64 + c4) = (f32x4){__expf(gl4[0]), __expf(gl4[1]), __expf(gl4[2]), __expf(gl4[3])};
        }
        BAR_LDS();
        {
            const int p = w >> 1, mt = w & 1;
            const LAS bf16* Ab = (p < 2) ? At : Rt; const LAS bf16* Bb = (p & 1) ? Kt_ : Bt_;
            const bf16x8 a0 = ldfrag(Ab + 16 * mt * 72, 72, lane), a1 = ldfrag(Ab + 16 * mt * 72 + 32, 72, lane);
#pragma unroll
            for (int nt = 0; nt < 2; ++nt) {
                f32x4 acc = __builtin_amdgcn_mfma_f32_16x16x32_bf16(a0, ldfrag(Bb + 16 * nt * 72, 72, lane), (f32x4){0.f, 0.f, 0.f, 0.f}, 0, 0, 0);
                acc = __builtin_amdgcn_mfma_f32_16x16x32_bf16(a1, ldfrag(Bb + 16 * nt * 72 + 32, 72, lane), acc, 0, 0, 0);
                const int sidx = 16 * nt + r16, tb = 16 * mt + 4 * q;
                float m[4];
#pragma unroll
                for (int i = 0; i < 4; ++i) m[i] = (p < 2 ? (sidx < tb + i) : (sidx <= tb + i)) ? acc[i] : 0.f;
                if (p == 0) {
#pragma unroll
                    for (int i = 0; i < 4; ++i) Lm[(tb + i) * 36 + sidx] = m[i];
                } else if (p == 1) { u32x2 pp; pp.x = pk2(m[0], m[1]); pp.y = pk2(m[2], m[3]); *(LAS u32x2*)(AKT + sidx * 40 + tb) = pp; }
                else { bf16* dst = (bf16*)(p == 2 ? ca + 12288 : cb + 8192);
#pragma unroll
                    for (int i = 0; i < 4; ++i) dst[(tb + i) * 32 + sidx] = (bf16)f2bf(m[i]); }
            }
        }
        BAR_LDS();
        if (w == 0) {
            const int c = lane & 31; float Tc[32];
#pragma unroll
            for (int tt = 0; tt < 32; ++tt) { float acc = (tt == c) ? 1.f : 0.f;
#pragma unroll
                for (int s2 = 0; s2 < tt; ++s2) acc = fmaf(Lm[tt * 36 + s2], Tc[s2], acc);
                Tc[tt] = acc; }
            if (lane < 32) {
#pragma unroll
                for (int tt = 0; tt < 32; ++tt) TI[tt * 40 + c] = (bf16)f2bf(Tc[tt]); }
        }
        BAR_LDS();
        if (w < 4) {
            const bf16x8 af = ldfrag(AT + 16 * w * 40, 40, lane);
#pragma unroll
            for (int nt = 0; nt < 2; ++nt) {
                const f32x4 acc = __builtin_amdgcn_mfma_f32_16x16x32_bf16(af, ldfrag(TI + 16 * nt * 40, 40, lane), (f32x4){0.f, 0.f, 0.f, 0.f}, 0, 0, 0);
                u32x2 pp; pp.x = pk2(acc[0], acc[1]); pp.y = pk2(acc[2], acc[3]);
                *(u32x2*)(ca + ((16 * nt + r16) * 64 + 16 * w + 4 * q) * 2) = pp;
            }
            const int ms = w >> 1, nt = w & 1;
            const f32x4 acc = __builtin_amdgcn_mfma_f32_16x16x32_bf16(ldfrag(AKT + 16 * ms * 40, 40, lane), ldfrag(TI + 16 * nt * 40, 40, lane), (f32x4){0.f, 0.f, 0.f, 0.f}, 0, 0, 0);
            u32x2 pp; pp.x = pk2(acc[0], acc[1]); pp.y = pk2(acc[2], acc[3]);
            *(u32x2*)(cb + 10240 + ((16 * nt + r16) * 32 + 16 * ms + 4 * q) * 2) = pp;
        } else {
            const int tt = tid - 256, row = tt >> 2, part = tt & 3;
            *(u32x4*)(cb + row * 64 + part * 16) = *(const LAS u32x4*)(KhT + row * 40 + part * 8);
            *(u32x4*)(cb + 4096 + row * 64 + part * 16) = *(const LAS u32x4*)(VT + row * 40 + part * 8);
        }
    }
}

__device__ __forceinline__ void rwkv_seq(const Args& a, LAS unsigned char* lds, int bh) {
    const int tid = threadIdx.x, lane = tid & 63, w = tid >> 6, q = lane >> 4, r16 = lane & 15;
    unsigned char* ws = a.ws;
    const unsigned char* __restrict__ CA = ws + WS_CA; const unsigned char* __restrict__ CB = (const unsigned char*)a.out + DO_CB; const float* __restrict__ CG = (const float*)(ws + WS_CG);
    float* __restrict__ Y = (float*)(ws + WS_Y);
    LAS bf16* HT = (LAS bf16*)lds; LAS bf16* UT = HT + 4608; LAS bf16* SL = UT + 2560;
    const int mt1 = w >> 2, mk = w >> 1, ntH = 2 * (w & 1), usel = (w >> 1) & 1, nt1 = ntH + usel;
    int gofs[4], ldst[4]; bool inB[4], val[4];
#pragma unroll
    for (int r = 0; r < 4; ++r) {
        const int idx = tid + 512 * r; val[r] = idx < 1664; inB[r] = idx >= 896;
        int ld;
        if (idx < 896) { const int i2 = idx; gofs[r] = i2 * 16;
            if (i2 < 256) ld = (i2 >> 3) * 72 + (i2 & 7) * 8;
            else if (i2 < 512) ld = 2304 + ((i2 - 256) >> 3) * 72 + ((i2 - 256) & 7) * 8;
            else if (i2 < 768) ld = 4608 + ((i2 - 512) >> 2) * 40 + ((i2 - 512) & 3) * 8;
            else ld = 7168 + ((i2 - 768) >> 2) * 40 + ((i2 - 768) & 3) * 8;
        } else { const int j2 = idx - 896; gofs[r] = j2 * 16;
            if (j2 < 256) ld = 8448 + (j2 >> 2) * 40 + (j2 & 3) * 8;
            else if (j2 < 512) ld = 11008 + ((j2 - 256) >> 2) * 40 + ((j2 - 256) & 3) * 8;
            else if (j2 < 640) ld = 13568 + ((j2 - 512) >> 2) * 40 + ((j2 - 512) & 3) * 8;
            else ld = 14848 + ((j2 - 640) >> 2) * 40 + ((j2 - 640) & 3) * 8;
        }
        ldst[r] = ld;
    }
    u32x4 st[4]; f32x4 gcur, gnx;
#define RS_LOAD(n) do { const size_t it_ = (size_t)(n) * 32 + bh; const unsigned char* ca = CA + it_ * CA_SZ; const unsigned char* cb = CB + it_ * CB_SZ; \
        _Pragma("unroll") for (int r = 0; r < 4; ++r) if (val[r]) st[r] = *(const u32x4*)((inB[r] ? cb : ca) + gofs[r]); \
        gnx = *(const f32x4*)(CG + it_ * 64 + 16 * mk + 4 * q); } while (0)
#define RS_PUT(n) do { LAS bf16* sl = SL + ((n) & 1) * 16128; _Pragma("unroll") for (int r = 0; r < 4; ++r) if (val[r]) *(LAS u32x4*)(sl + ldst[r]) = st[r]; } while (0)
    f32x4 H0 = (f32x4){0.f, 0.f, 0.f, 0.f}, H1 = H0;
    for (int i = tid; i < 4608 / 8; i += 512) *(LAS u32x4*)(HT + 8 * i) = (u32x4){0u, 0u, 0u, 0u};
    RS_LOAD(0); RS_PUT(0); gcur = gnx;
    BAR_LDS();
    for (int n = 0; n < T / 32; ++n) {
        RS_LOAD((n + 1 < T / 32 ? n + 1 : T / 32 - 1));
        const LAS bf16* sl = SL + (n & 1) * 16128;
        const bf16x8 h0 = ldfrag(HT + 16 * nt1 * 72, 72, lane), h1 = ldfrag(HT + 16 * nt1 * 72 + 32, 72, lane);
        const bf16x8 vth0 = ldfrag(sl + 11008 + 16 * ntH * 40, 40, lane), vth1 = ldfrag(sl + 11008 + (16 * ntH + 16) * 40, 40, lane);
        const bf16x8 vtu = usel ? vth1 : vth0;
        f32x4 u = __builtin_amdgcn_mfma_f32_16x16x32_bf16(ldfrag(sl + 14848 + 16 * mt1 * 40, 40, lane), vtu, (f32x4){0.f, 0.f, 0.f, 0.f}, 0, 0, 0);
        u = __builtin_amdgcn_mfma_f32_16x16x32_bf16(ldfrag(sl + 16 * mt1 * 72, 72, lane), h0, u, 0, 0, 0);
        u = __builtin_amdgcn_mfma_f32_16x16x32_bf16(ldfrag(sl + 16 * mt1 * 72 + 32, 72, lane), h1, u, 0, 0, 0);
        f32x4 y = __builtin_amdgcn_mfma_f32_16x16x32_bf16(ldfrag(sl + 13568 + 16 * mt1 * 40, 40, lane), vtu, (f32x4){0.f, 0.f, 0.f, 0.f}, 0, 0, 0);
        y = __builtin_amdgcn_mfma_f32_16x16x32_bf16(ldfrag(sl + 2304 + 16 * mt1 * 72, 72, lane), h0, y, 0, 0, 0);
        y = __builtin_amdgcn_mfma_f32_16x16x32_bf16(ldfrag(sl + 2304 + 16 * mt1 * 72 + 32, 72, lane), h1, y, 0, 0, 0);
        const bf16x8 kh = ldfrag(sl + 8448 + 16 * mk * 40, 40, lane);
        f32x4 hn0 = __builtin_amdgcn_mfma_f32_16x16x32_bf16(kh, vth0, gcur * H0, 0, 0, 0);
        f32x4 hn1 = __builtin_amdgcn_mfma_f32_16x16x32_bf16(kh, vth1, gcur * H1, 0, 0, 0);
        { u32x2 pp; pp.x = pk2(u[0], u[1]); pp.y = pk2(u[2], u[3]); *(LAS u32x2*)(UT + (16 * nt1 + r16) * 40 + 16 * mt1 + 4 * q) = pp; }
        BAR_LDS();
        y = __builtin_amdgcn_mfma_f32_16x16x32_bf16(ldfrag(sl + 7168 + 16 * mt1 * 40, 40, lane), ldfrag(UT + 16 * nt1 * 40, 40, lane), y, 0, 0, 0);
        *(f32x4*)(Y + (((size_t)bh * 256 + n) * 64 + 16 * nt1 + r16) * 32 + 16 * mt1 + 4 * q) = y;
        { const bf16x8 bhf = ldfrag(sl + 4608 + 16 * mk * 40, 40, lane);
          H0 = __builtin_amdgcn_mfma_f32_16x16x32_bf16(bhf, ldfrag(UT + 16 * ntH * 40, 40, lane), hn0, 0, 0, 0);
          H1 = __builtin_amdgcn_mfma_f32_16x16x32_bf16(bhf, ldfrag(UT + (16 * ntH + 16) * 40, 40, lane), hn1, 0, 0, 0);
          u32x2 pp; pp.x = pk2(H0[0], H0[1]); pp.y = pk2(H0[2], H0[3]); *(LAS u32x2*)(HT + (16 * ntH + r16) * 72 + 16 * mk + 4 * q) = pp;
          pp.x = pk2(H1[0], H1[1]); pp.y = pk2(H1[2], H1[3]); *(LAS u32x2*)(HT + (16 * ntH + 16 + r16) * 72 + 16 * mk + 4 * q) = pp; }
        RS_PUT(n + 1); gcur = gnx;
        BAR_LDS();
    }
#undef RS_LOAD
#undef RS_PUT
}
__device__ __forceinline__ void phase3(const Args& a, LAS unsigned char* lds) {
    for (int item = blockIdx.x; item < 64; item += gridDim.x) {
        __syncthreads();
        if (item < 32) rwkv_seq(a, lds, item); else hgrn_seq(a, lds, (item - 32) >> 1, (item - 32) & 1);
    }
}

__device__ __forceinline__ float red8(float v) { v = dpp_add<0xB1>(v); v = dpp_add<0x4E>(v); v = dpp_add<0x141>(v); return v; }
__device__ __forceinline__ void phase4(const Args& a, LAS unsigned char* lds) {
    const int tid = threadIdx.x, lane = tid & 63, wave = tid >> 6, gw = blockIdx.x * 8 + wave, NGW = gridDim.x * 8, tk = lane >> 3, cg = lane & 7;
    unsigned char* ws = a.ws;
    bf16* __restrict__ MIX = (bf16*)(ws + WS_MIX);
    const float* __restrict__ Y = (const float*)(ws + WS_Y); const float* __restrict__ OH = (const float*)(a.ws + WS_OH);
    const bf16* __restrict__ R = (const bf16*)(ws + WS_R); const bf16* __restrict__ KM = (const bf16*)(ws + WS_KM); const bf16* __restrict__ V = (const bf16*)(ws + WS_V); const bf16* __restrict__ G = (const bf16*)((unsigned char*)a.out + DO_G);
    const bf16* __restrict__ HG = (const bf16*)(ws + WS_HG);
    const float* __restrict__ r_k = a.in[13]; const float* __restrict__ ln_w = a.in[14]; const float* __restrict__ ln_b = a.in[15]; const float* __restrict__ hnw = a.in[4];
    LAS float* Yt = (LAS float*)(lds + wave * 17408);
    constexpr int N_RW = 32 * 128, N_HG = 16 * 128;
    for (int it = gw; it < N_RW + N_HG; it += NGW) {
        if (it < N_RW) {
            const int bh = it >> 7, tile = it & 127, b = bh >> 3, h = bh & 7, t0 = tile * 64;
            const float* yp = Y + ((size_t)bh * 256 + 2 * tile + (lane >> 5)) * 64 * 32 + (lane & 31);
#pragma unroll 16
            for (int v = 0; v < 64; ++v) Yt[v * 65 + lane] = yp[v * 32];
            asm volatile("s_waitcnt lgkmcnt(0)" ::: "memory");
            const int c = 64 * h + 8 * cg;
            const f32x4 k0 = *(const f32x4*)(r_k + c), k1 = *(const f32x4*)(r_k + c + 4), w0 = *(const f32x4*)(ln_w + c), w1 = *(const f32x4*)(ln_w + c + 4), b0 = *(const f32x4*)(ln_b + c), b1 = *(const f32x4*)(ln_b + c + 4);
            const float kr[8] = {k0.x, k0.y, k0.z, k0.w, k1.x, k1.y, k1.z, k1.w}, lw[8] = {w0.x, w0.y, w0.z, w0.w, w1.x, w1.y, w1.z, w1.w}, lb[8] = {b0.x, b0.y, b0.z, b0.w, b1.x, b1.y, b1.z, b1.w};
#pragma unroll 2
            for (int i = 0; i < 8; ++i) {
                const int tok = 8 * i + tk; const size_t row = (size_t)b * T + t0 + tok, o = row * 512 + c;
                const u32x4 rr = *(const u32x4*)(R + o), kk = *(const u32x4*)(KM + o), vv = *(const u32x4*)(V + o), gg = *(const u32x4*)(G + o);
                float y[8]; float s = 0.f;
#pragma unroll
                for (int j = 0; j < 8; ++j) { y[j] = Yt[(8 * cg + j) * 65 + tok]; s += y[j]; }
                const float mu = red8(s) * (1.f / 64.f); float q = 0.f;
#pragma unroll
                for (int j = 0; j < 8; ++j) { y[j] -= mu; q += y[j] * y[j]; }
                const float rs = __builtin_amdgcn_rsqf(red8(q) * (1.f / 64.f) + 64e-5f);
                const float rv[8] = {bflo(rr.x), bfhi(rr.x), bflo(rr.y), bfhi(rr.y), bflo(rr.z), bfhi(rr.z), bflo(rr.w), bfhi(rr.w)};
                const float kv[8] = {bflo(kk.x), bfhi(kk.x), bflo(kk.y), bfhi(kk.y), bflo(kk.z), bfhi(kk.z), bflo(kk.w), bfhi(kk.w)};
                const float vf[8] = {bflo(vv.x), bfhi(vv.x), bflo(vv.y), bfhi(vv.y), bflo(vv.z), bfhi(vv.z), bflo(vv.w), bfhi(vv.w)};
                const float gf[8] = {bflo(gg.x), bfhi(gg.x), bflo(gg.y), bfhi(gg.y), bflo(gg.z), bfhi(gg.z), bflo(gg.w), bfhi(gg.w)};
                float dot = 0.f;
#pragma unroll
                for (int j = 0; j < 8; ++j) dot += rv[j] * kv[j] * kr[j];
                dot = red8(dot);
                float e[8];
#pragma unroll
                for (int j = 0; j < 8; ++j) e[j] = (y[j] * rs * lw[j] + lb[j] + dot * vf[j]) * gf[j];
                u32x4 ov; ov.x = pk2(e[0], e[1]); ov.y = pk2(e[2], e[3]); ov.z = pk2(e[4], e[5]); ov.w = pk2(e[6], e[7]);
                *(u32x4*)(MIX + row * 1024 + 512 + c) = ov;
            }
            asm volatile("s_waitcnt lgkmcnt(0)" ::: "memory");
        } else {
            const int i2 = it - N_RW, bh = i2 >> 7, tile = i2 & 127, b = bh >> 2, h = bh & 3, t0 = tile * 64;
            const float* op = OH + ((size_t)bh * 256 + 2 * tile + (lane >> 5)) * 128 * 32 + (lane & 31);
            float ss = 0.f;
#pragma unroll 16
            for (int v = 0; v < 128; ++v) { const float o = op[v * 32]; ss += o * o; }
            Yt[64 * 65 + lane] = __builtin_amdgcn_rsqf(ss * (1.f / 128.f) + 1e-6f);
            for (int half = 0; half < 2; ++half) {
#pragma unroll 16
                for (int v = 0; v < 64; ++v) Yt[v * 65 + lane] = op[(64 * half + v) * 32];
                asm volatile("s_waitcnt lgkmcnt(0)" ::: "memory");
                const int c = 128 * h + 64 * half + 8 * cg;
                const f32x4 w0 = *(const f32x4*)(hnw + c), w1 = *(const f32x4*)(hnw + c + 4);
                const float wv[8] = {w0.x, w0.y, w0.z, w0.w, w1.x, w1.y, w1.z, w1.w};
#pragma unroll 2
                for (int i = 0; i < 8; ++i) {
                    const int tok = 8 * i + tk; const size_t row = (size_t)b * T + t0 + tok;
                    const u32x4 gg = *(const u32x4*)(HG + row * 2048 + 1536 + c);
                    const float rs = Yt[64 * 65 + tok];
                    const float gf[8] = {bflo(gg.x), bfhi(gg.x), bflo(gg.y), bfhi(gg.y), bflo(gg.z), bfhi(gg.z), bflo(gg.w), bfhi(gg.w)};
                    float e[8];
#pragma unroll
                    for (int j = 0; j < 8; ++j) e[j] = Yt[(8 * cg + j) * 65 + tok] * rs * wv[j] * gf[j] * sigmf(gf[j]);
                    u32x4 ov; ov.x = pk2(e[0], e[1]); ov.y = pk2(e[2], e[3]); ov.z = pk2(e[4], e[5]); ov.w = pk2(e[6], e[7]);
                    *(u32x4*)(MIX + row * 1024 + c) = ov;
                }
                asm volatile("s_waitcnt lgkmcnt(0)" ::: "memory");
            }
        }
    }
}

__device__ __forceinline__ void phase8(const Args& a) {
    const int tid = threadIdx.x, lane = tid & 63, wave = tid >> 6, gw = blockIdx.x * 8 + wave, NGW = gridDim.x * 8;
    const float* fw = a.in[21]; const float* ssq = (const float*)(a.ws + WS_SSQ2);
    f32x4 wv[4];
#pragma unroll
    for (int j = 0; j < 4; ++j) wv[j] = *((const f32x4*)fw + 64 * j + lane);
    for (int m = gw; m < M; m += NGW) {
        const float rstd = __builtin_amdgcn_rsqf(ssq[m] * (1.f / D) + 1e-6f);
        f32x4* xr = (f32x4*)(a.out + (size_t)m * D) + lane;
#pragma unroll
        for (int j = 0; j < 4; ++j) { f32x4 v = xr[64 * j]; v = v * rstd * wv[j]; xr[64 * j] = v; }
    }
}

__global__ void __launch_bounds__(512, 2) fwd_kernel(Args a) {
    extern __shared__ __attribute__((aligned(16))) unsigned char lds_raw[];
    LAS unsigned char* lds = (LAS unsigned char*)lds_raw;
    cg::grid_group grid = cg::this_grid();
    unsigned char* ws = a.ws;
    volatile LAS unsigned* bst = (volatile LAS unsigned*)(lds + LDS_BYTES - 16);
    if (threadIdx.x < 4) bst[threadIdx.x] = 0u;
    __syncthreads();
    XcdBarrier xbar = xcd_barrier_post((unsigned*)(ws + WS_BAR), bst);
    const int lo = a.ph_lo, hi = a.ph_hi;
#define IN(k) (lo <= (k) && (k) < hi)
#define SEAM(k) do { if ((k) + 1 < hi) { if ((k) == 0) grid.sync(); else xcd_barrier(xbar); } } while (0)
    {
        if (IN(0)) { phase0(a, lds); SEAM(0); }
        if (IN(1)) {
            pg8::Gemm g{(const pg8::bf16_t*)((unsigned char*)a.out + DO_XN), (const pg8::bf16_t*)(ws + WS_WTIN), M, 3840, 1024}; pg8::StaticOrder S; S.init(M, 3840, gridDim.x, blockIdx.x);
            pg8::EpiProj E{(pg8::bf16_t*)(ws + WS_HG), (pg8::bf16_t*)(ws + WS_RW), (const float*)(ws + WS_LB)};
            pg8::gemm_phase<pg8::EpiProj, pg8::StaticOrder>((PG8_LAS unsigned char*)lds, g, S, E, nullptr); SEAM(1);
        }
        if (IN(2)) { phase2(a, lds); phase2h(a); SEAM(2); }
        if (IN(3)) { phase2c(a, lds); SEAM(3); }
        if (IN(4)) { phase3(a, lds); SEAM(4); }
        if (IN(5)) { phase4(a, lds); SEAM(5); }
        if (IN(6)) {
            pg8::Gemm g{(const pg8::bf16_t*)(ws + WS_MIX), (const pg8::bf16_t*)(ws + WS_WTOUT), M, 1024, 1024}; pg8::StaticOrder S; S.init(M, 1024, gridDim.x, blockIdx.x);
            pg8::EpiRes<true> E{a.in[0], a.out, (pg8::bf16_t*)(ws + WS_X1B), a.in[17], (float*)(ws + WS_SSQ1)};
            pg8::gemm_phase<pg8::EpiRes<true>, pg8::StaticOrder>((PG8_LAS unsigned char*)lds, g, S, E, nullptr); SEAM(6);
        }
        if (IN(7)) {
            pg8::Gemm g{(const pg8::bf16_t*)(ws + WS_X1B), (const pg8::bf16_t*)(ws + WS_WT13), M, 2 * FF, 1024}; pg8::StaticOrder S; S.init(M, 2 * FF, gridDim.x, blockIdx.x);
            pg8::EpiGlu E{(pg8::bf16_t*)(ws + WS_U), (const float*)(ws + WS_SSQ1)};
            pg8::gemm_phase<pg8::EpiGlu, pg8::StaticOrder>((PG8_LAS unsigned char*)lds, g, S, E, nullptr); SEAM(7);
        }
        if (IN(8)) {
            pg8::Gemm g{(const pg8::bf16_t*)(ws + WS_U), (const pg8::bf16_t*)(ws + WS_WT2), M, 1024, FF}; pg8::StaticOrder S; S.init(M, 1024, gridDim.x, blockIdx.x);
            pg8::EpiRes<false> E{a.out, a.out, nullptr, nullptr, (float*)(ws + WS_SSQ2)};
            pg8::gemm_phase<pg8::EpiRes<false>, pg8::StaticOrder>((PG8_LAS unsigned char*)lds, g, S, E, nullptr); SEAM(8);
        }
        if (IN(9)) phase8(a);
    }
#undef IN
#undef SEAM
}

extern "C" void kernel_launch(void* const* d_in, const int* in_sizes, int n_in, void* d_out, int out_size, void* d_ws, size_t ws_size, hipStream_t stream) {
    static int grid = 0;
    if (grid == 0) {
        if (n_in != 22 || out_size != M * D || ws_size < WS_END) { fprintf(stderr, "kernel_launch: unexpected problem (n_in %d, out %d, ws %zu)\n", n_in, out_size, ws_size); grid = -1; return; }
        int dev = 0, cus = 0, per_cu = 0;
        if (hipGetDevice(&dev) != hipSuccess || hipDeviceGetAttribute(&cus, hipDeviceAttributeMultiprocessorCount, dev) != hipSuccess) { grid = -1; return; }
        if (hipFuncSetAttribute((const void*)fwd_kernel, hipFuncAttributeMaxDynamicSharedMemorySize, LDS_BYTES) != hipSuccess) { fprintf(stderr, "kernel_launch: hipFuncSetAttribute failed\n"); grid = -1; return; }
        if (hipOccupancyMaxActiveBlocksPerMultiprocessor(&per_cu, (const void*)fwd_kernel, 512, LDS_BYTES) != hipSuccess || per_cu < 1) { fprintf(stderr, "kernel_launch: occupancy query says %d\n", per_cu); per_cu = 1; }
        (void)hipGetLastError();
        grid = cus * 1;
    }
    if (grid < 0) return;
    if (hipMemsetAsync((char*)d_ws + WS_BAR, 0, 16384, stream) != hipSuccess) { fprintf(stderr, "kernel_launch: memset failed\n"); return; }
    Args a{};
    for (int i = 0; i < 22; ++i) a.in[i] = (const float*)d_in[i];
    a.out = (float*)d_out; a.ws = (unsigned char*)d_ws;
    if (N_LAUNCHES == 1) {
        a.ph_lo = 0; a.ph_hi = NPHASE;
        void* args[] = {&a};
        hipError_t e = hipLaunchCooperativeKernel((const void*)fwd_kernel, dim3(grid), dim3(512), args, LDS_BYTES, stream);
        if (e != hipSuccess) fprintf(stderr, "cooperative launch failed: %s (grid %d)\n", hipGetErrorString(e), grid);
    } else {
        for (int ph = 0; ph < NPHASE; ++ph) { a.ph_lo = ph; a.ph_hi = ph + 1; hipLaunchKernelGGL(fwd_kernel, dim3(grid), dim3(512), LDS_BYTES, stream, a);
#ifdef PROBE_DUP
            if (ph == PROBE_DUP) hipLaunchKernelGGL(fwd_kernel, dim3(grid), dim3(512), LDS_BYTES, stream, a);
#endif
        }
    }
}
```

```cpp
#include <hip/hip_runtime.h>
#include <hip/hip_cooperative_groups.h>
#include <cstdio>
namespace cg = cooperative_groups;
namespace pg8 {
#define PG8_LAS __attribute__((address_space(3)))
typedef unsigned short bf16_t;
typedef short bf16x8 __attribute__((ext_vector_type(8)));
typedef float f32x4 __attribute__((ext_vector_type(4)));
typedef unsigned u32x4 __attribute__((ext_vector_type(4)));
constexpr int BM = 256, BK = 64, HALF = 128, HTB = HALF * BK * 2  , STAGE_BYTES = 8 * HTB, NXCD = 8, WGM = 8;

__host__ __device__ __forceinline__ int lds_byte(int r, int c) { const int st = (r >> 4) * 2 + (c >> 5), rr = r & 15, cc = c & 31, ob = rr * 64 + cc * 2; return st * 1024 + (ob ^ (((ob >> 9) & 1) << 5)); }
__host__ __device__ __forceinline__ void stage_rc(int b, int& R, int& C) { const int st = b / 1024, sb = b % 1024, swz = sb ^ (((sb >> 9) & 1) << 5); R = (st >> 1) * 16 + swz / 64; C = (st & 1) * 32 + (swz % 64) / 2; }
__host__ __device__ __forceinline__ int perm32(int rho) { const int n = rho >> 4, i = rho & 15; return 8 * (i >> 2) + 4 * n + (i & 3); }

struct Unit { int pm, pn; };
struct Gemm { const bf16_t* A; const bf16_t* Bt; int M, N, K; };

struct StaticOrder {
    int nM, nN, nwg, G, c;
    __host__ __device__ void init(int M, int N, int G_, int c_) { nM = M / BM; nN = N / BM; nwg = nM * nN; G = G_; c = c_; }
    __host__ __device__ bool next(int i, Unit& u) const {
        const long L = (long)i * G + c; if (L >= nwg) return false;
        int wgid = (int)L; { const int q = nwg / NXCD, r = nwg % NXCD, xcd = wgid % NXCD, off = wgid / NXCD; wgid = (xcd < r ? xcd * (q + 1) : r * (q + 1) + (xcd - r) * q) + off; }
        const int nig = WGM * nN, gid = wgid / nig, fm = gid * WGM, gsz = (nM - fm) < WGM ? (nM - fm) : WGM;
        u.pm = fm + ((wgid % nig) % gsz); u.pn = (wgid % nig) / gsz; return true;
    }
    __device__ __forceinline__ void a_ready(const Unit&) const {}
    __device__ __forceinline__ void done(const Unit&) const {}
};
__device__ __forceinline__ unsigned cvt_pk_bf16(float lo, float hi) { unsigned r; asm volatile("v_cvt_pk_bf16_f32 %0, %1, %2" : "=v"(r) : "v"(lo), "v"(hi)); return r; }
__device__ __forceinline__ float sigm(float v) { return __builtin_amdgcn_rcpf(1.0f + __expf(-v)); }
struct EpiProj {
    static constexpr bool PERM = true, AFTER_DRAIN = false;
    bf16_t* HG; bf16_t* RW; const float* LB;
    __device__ __forceinline__ void operator()(const f32x4 (&acc)[2][2][4][2], const Unit& u, int wr, int wc, int fr, int fq) const {
        const int row0 = u.pm * BM + wr * 64 + fr, cb = u.pn * BM + wc * 32 + 8 * fq;
        const int mode = u.pn < 2 ? 0 : (u.pn < 4 ? 1 : 2);
#pragma unroll
        for (int bj = 0; bj < 2; ++bj) {
            const int col = cb + bj * HALF;
            f32x4 l0 = (f32x4){0.f, 0.f, 0.f, 0.f}, l1 = l0;
            if (mode == 1) { l0 = *(const f32x4*)(LB + col - 512); l1 = *(const f32x4*)(LB + col - 512 + 4); }
#pragma unroll
            for (int ai = 0; ai < 2; ++ai)
#pragma unroll
                for (int m = 0; m < 4; ++m) {
                    const int row = row0 + ai * HALF + m * 16;
                    f32x4 v0 = acc[ai][bj][m][0], v1 = acc[ai][bj][m][1];
                    if (mode == 0) {
#pragma unroll
                        for (int j = 0; j < 4; ++j) { v0[j] = v0[j] * sigm(v0[j]); v1[j] = v1[j] * sigm(v1[j]); }
                    } else if (mode == 1) {
#pragma unroll
                        for (int j = 0; j < 4; ++j) { v0[j] = l0[j] + (1.0f - l0[j]) * sigm(v0[j]); v1[j] = l1[j] + (1.0f - l1[j]) * sigm(v1[j]); }
                    }
                    u32x4 w; w.x = cvt_pk_bf16(v0[0], v0[1]); w.y = cvt_pk_bf16(v0[2], v0[3]); w.z = cvt_pk_bf16(v1[0], v1[1]); w.w = cvt_pk_bf16(v1[2], v1[3]);
                    bf16_t* dst = (u.pn < 8) ? HG + (size_t)row * 2048 + col : RW + (size_t)row * 1792 + (col - 2048);
                    *(u32x4*)dst = w;
                }
        }
    }
};
template <bool WB> struct EpiRes {
    static constexpr bool PERM = true, AFTER_DRAIN = false;
    const float* X; float* X1; bf16_t* X1B; const float* NW; float* SSQ;
    __device__ __forceinline__ void operator()(const f32x4 (&acc)[2][2][4][2], const Unit& u, int wr, int wc, int fr, int fq) const {
        const int row0 = u.pm * BM + wr * 64 + fr, cb = u.pn * BM + wc * 32 + 8 * fq;
#pragma unroll
        for (int ai = 0; ai < 2; ++ai)
#pragma unroll
            for (int m = 0; m < 4; ++m) {
                const int row = row0 + ai * HALF + m * 16; float ss = 0.f;
#pragma unroll
                for (int bj = 0; bj < 2; ++bj) {
                    const size_t off = (size_t)row * 1024 + cb + bj * HALF;
                    f32x4 v0 = acc[ai][bj][m][0] + *(const f32x4*)(X + off), v1 = acc[ai][bj][m][1] + *(const f32x4*)(X + off + 4);
                    *(f32x4*)(X1 + off) = v0; *(f32x4*)(X1 + off + 4) = v1;
                    ss += (v0[0] * v0[0] + v0[1] * v0[1]) + (v0[2] * v0[2] + v0[3] * v0[3]) + (v1[0] * v1[0] + v1[1] * v1[1]) + (v1[2] * v1[2] + v1[3] * v1[3]);
                    if (WB) { const f32x4 n0 = *(const f32x4*)(NW + cb + bj * HALF), n1 = *(const f32x4*)(NW + cb + bj * HALF + 4);
                        u32x4 w; w.x = cvt_pk_bf16(v0[0] * n0[0], v0[1] * n0[1]); w.y = cvt_pk_bf16(v0[2] * n0[2], v0[3] * n0[3]); w.z = cvt_pk_bf16(v1[0] * n1[0], v1[1] * n1[1]); w.w = cvt_pk_bf16(v1[2] * n1[2], v1[3] * n1[3]);
                        *(u32x4*)(X1B + off) = w; }
                }
                ss += __shfl_xor(ss, 16); ss += __shfl_xor(ss, 32);
                if (fq == 0) unsafeAtomicAdd(SSQ + row, ss);
            }
    }
};
struct EpiGlu {
    static constexpr bool PERM = true, AFTER_DRAIN = false;
    bf16_t* U; const float* SSQ;
    __device__ __forceinline__ void operator()(const f32x4 (&acc)[2][2][4][2], const Unit& u, int wr, int wc, int fr, int fq) const {
        const int row0 = u.pm * BM + wr * 64 + fr, cb = (u.pn * BM + wc * 32 + 8 * fq) >> 1;
#pragma unroll
        for (int ai = 0; ai < 2; ++ai)
#pragma unroll
            for (int m = 0; m < 4; ++m) {
                const int row = row0 + ai * HALF + m * 16;
                const float rstd = __builtin_amdgcn_rsqf(SSQ[row] * (1.0f / 1024.0f) + 1e-6f);
#pragma unroll
                for (int bj = 0; bj < 2; ++bj) {
                    const f32x4 g = acc[ai][bj][m][0] * rstd, up = acc[ai][bj][m][1] * rstd; float h[4];
#pragma unroll
                    for (int j = 0; j < 4; ++j) h[j] = g[j] * sigm(g[j]) * up[j];
                    typedef unsigned u32x2 __attribute__((ext_vector_type(2)));
                    u32x2 w; w.x = cvt_pk_bf16(h[0], h[1]); w.y = cvt_pk_bf16(h[2], h[3]);
                    *(u32x2*)(U + (size_t)row * 2816 + cb + bj * (HALF / 2)) = w;
                }
            }
    }
};

template <class Epi, class Sched, bool STAMP = false>
__device__ __forceinline__ void gemm_phase(PG8_LAS unsigned char* lds, const Gemm g, const Sched& S, const Epi& E, unsigned long long* stamps) {
    const int tid = threadIdx.x, wid = __builtin_amdgcn_readfirstlane(tid >> 6), lane = tid & 63, wr = wid >> 2, wc = wid & 3, fr = lane & 15, fq = lane >> 4;
    const int K = g.K, nt = K / BK;
    int ts_lo = 0, ts_hi = 0, nts = 0; const unsigned long long rt_entry = STAMP ? (unsigned long long)wall_clock64() : 0ull;
#define PG8_STAMP() do { if (STAMP && wid == 0 && nts < 64) { const unsigned long long _c = (unsigned long long)clock64(); \
        ts_lo = (lane == nts) ? (int)(unsigned)_c : ts_lo; ts_hi = (lane == nts) ? (int)(unsigned)(_c >> 32) : ts_hi; ++nts; } } while (0)
    PG8_STAMP();
    unsigned voffA[2], voffB[2];
#pragma unroll
    for (int i = 0; i < 2; ++i) { int R, C; stage_rc(tid * 16 + i * 8192, R, C); const int Rb = Epi::PERM ? ((R & ~31) + perm32(R & 31)) : R;
        voffA[i] = (unsigned)(R * K + C) * 2u; voffB[i] = (unsigned)(Rb * K + C) * 2u; }
    const size_t kstep = (size_t)(BK * 2);
    const size_t hstep = (size_t)HALF * K * 2;
    const size_t tstep = 2 * hstep;
    const unsigned ldsw = (unsigned)wid * 1024u;
    const int aoff = lds_byte(wr * 64 + fr, fq * 8), boff = lds_byte(wc * 32 + fr, fq * 8);
#define PG8_SA(b, h) (((b) * 2 + (h)) * HTB)
#define PG8_SB(b, h) ((4 + (b) * 2 + (h)) * HTB)
#define PG8_STAGE(bufoff, gbase, voff) do { _Pragma("unroll") for (int _i = 0; _i < 2; ++_i) \
        __builtin_amdgcn_global_load_lds((const unsigned*)((const char*)(gbase) + (voff)[_i]), (PG8_LAS unsigned*)(lds + (bufoff) + ldsw + _i * 8192), 16, 0, 0); } while (0)
#define PG8_LDA(dst, b, h) do { _Pragma("unroll") for (int m = 0; m < 4; ++m) _Pragma("unroll") for (int k = 0; k < 2; ++k) dst[m][k] = *(const PG8_LAS bf16x8*)(lds + PG8_SA(b, h) + aoff + m * 2048 + k * 1024); } while (0)
#define PG8_LDB(dst, b, h) do { _Pragma("unroll") for (int n = 0; n < 2; ++n) _Pragma("unroll") for (int k = 0; k < 2; ++k) dst[n][k] = *(const PG8_LAS bf16x8*)(lds + PG8_SB(b, h) + boff + n * 2048 + k * 1024); } while (0)
#define PG8_MMA(ai, bj, At, Bt) do { __builtin_amdgcn_s_setprio(1); _Pragma("unroll") for (int m = 0; m < 4; ++m) _Pragma("unroll") for (int n = 0; n < 2; ++n) _Pragma("unroll") for (int k = 0; k < 2; ++k) \
        acc[ai][bj][m][n] = __builtin_amdgcn_mfma_f32_16x16x32_bf16(Bt[n][k], At[m][k], acc[ai][bj][m][n], 0, 0, 0); __builtin_amdgcn_s_setprio(0); } while (0)
#define PG8_WAIT_V(n) asm volatile("s_waitcnt vmcnt(" #n ")" ::: "memory")
#define PG8_WAIT_L(n) asm volatile("s_waitcnt lgkmcnt(" #n ")" ::: "memory")
#define PG8_BAR __builtin_amdgcn_s_barrier()
#define PG8_SCHED __builtin_amdgcn_sched_barrier(0)
    Unit cur, nxt; int ui = 0;
    if (!S.next(0, cur)) return;
    f32x4 acc[2][2][4][2];
#pragma unroll
    for (int a = 0; a < 2; ++a)
#pragma unroll
        for (int b = 0; b < 2; ++b)
#pragma unroll
            for (int m = 0; m < 4; ++m)
#pragma unroll
                for (int n = 0; n < 2; ++n) acc[a][b][m][n] = (f32x4){0.f, 0.f, 0.f, 0.f};
    bf16x8 At[4][2], B0[2][2], B1[2][2];
    const char* cA = (const char*)g.A + (size_t)cur.pm * tstep; const char* cB = (const char*)g.Bt + (size_t)cur.pn * tstep;
    S.a_ready(cur);
    PG8_STAGE(PG8_SB(0, 0), cB, voffB); PG8_STAGE(PG8_SA(0, 0), cA, voffA); PG8_STAGE(PG8_SB(0, 1), cB + hstep, voffB); PG8_STAGE(PG8_SA(0, 1), cA + hstep, voffA);
    if (wr == 1) PG8_BAR;
    PG8_WAIT_V(4); PG8_BAR;
    PG8_STAGE(PG8_SB(1, 0), cB + kstep, voffB); PG8_STAGE(PG8_SA(1, 0), cA + kstep, voffA); PG8_STAGE(PG8_SB(1, 1), cB + hstep + kstep, voffB);
    PG8_WAIT_V(6); PG8_BAR;
    PG8_STAMP();
    for (;;) {
        const bool has_next = S.next(ui + 1, nxt);
        const char* nA = has_next ? (const char*)g.A + (size_t)nxt.pm * tstep : cA; const char* nB = has_next ? (const char*)g.Bt + (size_t)nxt.pn * tstep : cB;
        for (int t = 0; t < nt; t += 2) {
            const bool last = (t == nt - 2);
            const char* a1 = cA + (size_t)(t + 1) * kstep;
            const char* a2 = last ? nA : cA + (size_t)(t + 2) * kstep; const char* b2 = last ? nB : cB + (size_t)(t + 2) * kstep;
            const char* a3 = a2 + kstep; const char* b3 = b2 + kstep;
            if (last && has_next) S.a_ready(nxt);
            PG8_LDB(B0, 0, 0); PG8_SCHED; PG8_LDA(At, 0, 0); PG8_STAGE(PG8_SA(1, 1), a1 + hstep, voffA);
            PG8_WAIT_L(8); PG8_BAR; PG8_WAIT_L(0); PG8_MMA(0, 0, At, B0); PG8_BAR; PG8_SCHED;
            PG8_LDB(B1, 0, 1); PG8_STAGE(PG8_SB(0, 0), b2, voffB);
            PG8_BAR; PG8_WAIT_L(0); PG8_MMA(0, 1, At, B1); PG8_BAR;
            PG8_LDA(At, 0, 1); PG8_STAGE(PG8_SA(0, 0), a2, voffA);
            PG8_BAR; PG8_WAIT_L(0); PG8_MMA(1, 0, At, B0); PG8_BAR; PG8_SCHED;
            PG8_STAGE(PG8_SB(0, 1), b2 + hstep, voffB);
            PG8_WAIT_V(6); PG8_BAR; PG8_MMA(1, 1, At, B1); PG8_BAR;
            PG8_LDB(B0, 1, 0); PG8_SCHED; PG8_LDA(At, 1, 0); PG8_STAGE(PG8_SA(0, 1), a2 + hstep, voffA);
            PG8_WAIT_L(8); PG8_BAR; PG8_WAIT_L(0); PG8_MMA(0, 0, At, B0); PG8_BAR; PG8_SCHED;
            PG8_LDB(B1, 1, 1); PG8_STAGE(PG8_SB(1, 0), b3, voffB);
            PG8_BAR; PG8_WAIT_L(0); PG8_MMA(0, 1, At, B1); PG8_BAR;
            PG8_LDA(At, 1, 1); PG8_STAGE(PG8_SA(1, 0), a3, voffA);
            PG8_BAR; PG8_WAIT_L(0); PG8_MMA(1, 0, At, B0); PG8_BAR; PG8_SCHED;
            PG8_STAGE(PG8_SB(1, 1), b3 + hstep, voffB);
            PG8_WAIT_V(6); PG8_BAR; PG8_MMA(1, 1, At, B1); PG8_BAR;
        }
        PG8_STAMP();
        if constexpr (!Epi::AFTER_DRAIN) { E(acc, cur, wr, wc, fr, fq); S.done(cur); }
        PG8_STAMP();
        if (!has_next) break;
#pragma unroll
        for (int a = 0; a < 2; ++a)
#pragma unroll
            for (int b = 0; b < 2; ++b)
#pragma unroll
                for (int m = 0; m < 4; ++m)
#pragma unroll
                    for (int n = 0; n < 2; ++n) acc[a][b][m][n] = (f32x4){0.f, 0.f, 0.f, 0.f};
        cur = nxt; cA = nA; cB = nB; ++ui;
    }
    PG8_WAIT_V(0);
    if (wr == 0) PG8_BAR;
    PG8_BAR;
    if constexpr (Epi::AFTER_DRAIN) { E.fused(acc, cur, wr, wc, fr, fq, lds, wid, lane); S.done(cur); }
    PG8_STAMP();
    if (STAMP && wid == 0) { stamps[lane] = lane < nts ? (((unsigned long long)(unsigned)ts_hi << 32) | (unsigned)ts_lo) : 0ull;
        if (lane == 62) stamps[62] = rt_entry; if (lane == 63) stamps[63] = (unsigned long long)wall_clock64(); }
#undef PG8_STAMP
#undef PG8_SA
#undef PG8_SB
#undef PG8_STAGE
#undef PG8_LDA
#undef PG8_LDB
#undef PG8_MMA
#undef PG8_WAIT_V
#undef PG8_WAIT_L
#undef PG8_BAR
#undef PG8_SCHED
}
}
#define LAS __attribute__((address_space(3)))
typedef unsigned short bf16;
typedef float f32x4 __attribute__((ext_vector_type(4)));
typedef unsigned u32x4 __attribute__((ext_vector_type(4)));
typedef unsigned u32x2 __attribute__((ext_vector_type(2)));
typedef float f32x2 __attribute__((ext_vector_type(2)));
typedef short bf16x8 __attribute__((ext_vector_type(8)));
constexpr int M = 32768, T = 8192, D = 1024, FF = 2816;
constexpr size_t MiB = 1u << 20;
constexpr size_t WS_LB = 0, WS_SSQ1 = 65536, WS_SSQ2 = 65536 + 131072;
constexpr size_t WS_WTIN = 2 * MiB, WS_WTOUT = 10 * MiB, WS_WT13 = 12 * MiB, WS_WT2 = 23 * MiB, WS_LT = 29 * MiB;
constexpr size_t WS_HG = 32 * MiB, WS_RW = 160 * MiB, WS_Y = 272 * MiB, WS_W = 272 * MiB, WS_KK = 336 * MiB, WS_BB = 368 * MiB, WS_KM = 400 * MiB, WS_R = 432 * MiB, WS_V = 464 * MiB;
constexpr size_t WS_GC = 496 * MiB;
constexpr size_t WS_MIX = 160 * MiB, WS_X1B = 272 * MiB, WS_U = 32 * MiB, WS_END = 500 * MiB;
constexpr size_t WS_CA = 160 * MiB, DO_CB = 32 * MiB, WS_CG = 498 * MiB, WS_OH = 336 * MiB;
constexpr int CA_SZ = 14336, CB_SZ = 12288;
constexpr size_t DO_XN = 0, DO_G = 0;
constexpr int LDS_BYTES = 147456;
constexpr int NPHASE = 10;
#ifndef N_LAUNCHES
#define N_LAUNCHES 1
#endif

__device__ __forceinline__ unsigned f2bf(float f) { unsigned u = __float_as_uint(f); return (u + 0x7fffu + ((u >> 16) & 1u)) >> 16; }
typedef __bf16 bf16x2_t __attribute__((ext_vector_type(2)));
__device__ __forceinline__ unsigned pk2(float lo, float hi) { f32x2 v = {lo, hi}; bf16x2_t b = __builtin_convertvector(v, bf16x2_t); return __builtin_bit_cast(unsigned, b); }
__device__ __forceinline__ float bflo(unsigned u) { return __uint_as_float(u << 16); }
__device__ __forceinline__ float bfhi(unsigned u) { return __uint_as_float(u & 0xffff0000u); }
__device__ __forceinline__ float bf1(bf16 b) { return __uint_as_float(((unsigned)b) << 16); }
__device__ __forceinline__ float sigmf(float v) { return __builtin_amdgcn_rcpf(1.0f + __expf(-v)); }
__device__ __forceinline__ float wave_sum(float v) {
#pragma unroll
    for (int o = 1; o < 64; o <<= 1) v += __shfl_xor(v, o);
    return v;
}
#define BAR_LDS() do { asm volatile("s_waitcnt lgkmcnt(0)" ::: "memory"); __builtin_amdgcn_s_barrier(); asm volatile("" ::: "memory"); } while (0)
template <int CTRL> __device__ __forceinline__ float dpp_add(float v) { return v + __int_as_float(__builtin_amdgcn_update_dpp(0, __float_as_int(v), CTRL, 0xf, 0xf, true)); }
__device__ __forceinline__ float rowsum16(float v) { v = dpp_add<0xB1>(v); v = dpp_add<0x4E>(v); v = dpp_add<0x141>(v); v = dpp_add<0x140>(v); return v; }

#define XB_TMO      128
#define XB_XCNT(j)  (256  + 64 * (j))
#define XB_XSUB(j)  (1280 + 64 * (j))
#define XB_XGEN(j)  (2304 + 64 * (j))
#define XB_TOP      3328
#define XB_TOPGEN   3392
#define XCD_BAR_WORDS 3456
#define XB_SPIN_CAP (1u << 18)

__device__ __forceinline__ unsigned xb_ld(unsigned* p)              { return __hip_atomic_load(p, __ATOMIC_RELAXED, __HIP_MEMORY_SCOPE_AGENT); }
__device__ __forceinline__ unsigned xb_add(unsigned* p, unsigned v) { return __hip_atomic_fetch_add(p, v, __ATOMIC_RELAXED, __HIP_MEMORY_SCOPE_AGENT); }
__device__ __forceinline__ unsigned xb_xcc_id() { return (unsigned)__builtin_amdgcn_s_getreg((3 << 11) | 20) & 0xFu; }
#define XB_SPIN(cond, bar) do { unsigned _sp = 0; while (cond) { __builtin_amdgcn_s_sleep(1); \
    if ((++_sp & 255u) == 0u) { if (xb_ld(&(bar)[XB_TMO])) break; if (_sp > XB_SPIN_CAP) { atomicAdd(&(bar)[XB_TMO], 1u); break; } } } } while (0)

struct XcdBarrier {
    unsigned* bar; unsigned x;
    volatile LAS unsigned* st;
};

__device__ __forceinline__ XcdBarrier xcd_barrier_post(unsigned* bar, volatile LAS unsigned* st) {
    XcdBarrier b; b.bar = bar; b.x = xb_xcc_id(); b.st = st;
    if (threadIdx.x == 0) (void)xb_add(&bar[XB_XCNT(b.x)], 1u);
    return b;
}
__device__ __forceinline__ void xcd_barrier_complete(unsigned* bar, unsigned x, unsigned& nloc, unsigned& nx) {
    const unsigned G = gridDim.x * gridDim.y * gridDim.z;
    unsigned sum, cnt, mine, sp = 0u;
    for (;;) {
        sum = 0u; cnt = 0u; mine = 0u;
#pragma unroll
        for (unsigned j = 0; j < 16; ++j) { const unsigned c = xb_ld(&bar[XB_XCNT(j)]); sum += c; cnt += (c > 0u) ? 1u : 0u; mine = (j == x) ? c : mine; }
        if (sum == G) break;
        __builtin_amdgcn_s_sleep(1);
        if ((++sp & 255u) == 0u) { if (xb_ld(&bar[XB_TMO])) break; if (sp > XB_SPIN_CAP) { atomicAdd(&bar[XB_TMO], 1u); break; } }
    }
    nloc = mine > 0u ? mine : 1u; nx = cnt > 0u ? cnt : 1u;
}

__device__ __forceinline__ void xcd_barrier(const XcdBarrier& b) {
    asm volatile("s_waitcnt vmcnt(0)" ::: "memory");
    __syncthreads();
    if (threadIdx.x == 0) {
        unsigned* bar = b.bar;
        __builtin_amdgcn_s_waitcnt(0);
        unsigned nloc = b.st[0], nx = b.st[1];
        if (nloc == 0u) { xcd_barrier_complete(bar, b.x, nloc, nx); b.st[0] = nloc; b.st[1] = nx; }
        const unsigned old = xb_add(&bar[XB_XSUB(b.x)], 1u);
        const unsigned gen = old / nloc;
        if (old + 1u == (gen + 1u) * nloc) {
            __builtin_amdgcn_fence(__ATOMIC_RELEASE, "agent");
            asm volatile("s_waitcnt vmcnt(0)" ::: "memory");
            const unsigned og = xb_add(&bar[XB_TOP], 1u);
            const unsigned tg = og / nx;
            if (og + 1u == (tg + 1u) * nx) xb_add(&bar[XB_TOPGEN], 1u);
            else XB_SPIN(xb_ld(&bar[XB_TOPGEN]) == tg, bar);
            __builtin_amdgcn_fence(__ATOMIC_ACQUIRE, "agent");
            xb_add(&bar[XB_XGEN(b.x)], 1u);
            asm volatile("s_waitcnt vmcnt(0)" ::: "memory");
        } else {
            XB_SPIN(xb_ld(&bar[XB_XGEN(b.x)]) == gen, bar);
            __builtin_amdgcn_fence(__ATOMIC_ACQUIRE, "agent");
            asm volatile("s_waitcnt vmcnt(0)" ::: "memory");
        }
    }
    __syncthreads();
}

constexpr size_t WS_BAR = 524288;
struct Args { const float* in[22]; float* out; unsigned char* ws; int ph_lo, ph_hi; };

__device__ __forceinline__ void p0_transpose_item(const float* W, int K, int N, bf16* WT, int ld, int koff, int mode, LAS float* scr, int item, int lane) {
    const int nblk = N / 32, kb = item / nblk, nb = item % nblk, k0 = 64 * kb, n0 = 32 * nb;
#pragma unroll 8
    for (int i = 0; i < 32; ++i) { const int kk = 2 * i + (lane >> 5); scr[kk * 33 + (lane & 31)] = W[(size_t)(k0 + kk) * N + n0 + (lane & 31)]; }
    asm volatile("s_waitcnt lgkmcnt(0)" ::: "memory");
    const int c = lane & 7;
#pragma unroll
    for (int j = 0; j < 4; ++j) { const int n = (lane >> 3) + 8 * j; const LAS float* s = scr + (8 * c) * 33 + n;
        u32x4 o; o.x = pk2(s[0 * 33], s[1 * 33]); o.y = pk2(s[2 * 33], s[3 * 33]); o.z = pk2(s[4 * 33], s[5 * 33]); o.w = pk2(s[6 * 33], s[7 * 33]);
        const int ng = n0 + n, row = mode == 0 ? ng : ((ng >> 2) * 8 + (ng & 3) + (mode == 2 ? 4 : 0));
        *(u32x4*)(WT + (size_t)row * ld + koff + k0 + 8 * c) = o; }
    asm volatile("s_waitcnt lgkmcnt(0)" ::: "memory");
}
__device__ __forceinline__ void phase0(const Args& a, LAS unsigned char* lds) {
    const int tid = threadIdx.x, lane = tid & 63, wave = tid >> 6, gw = blockIdx.x * 8 + wave, NGW = gridDim.x * 8;
    unsigned char* ws = a.ws;
    LAS float* scr = (LAS float*)(lds + wave * 16384);
    constexpr int I_IN = 16 * 120, I_OUT = 16 * 32, I_1 = 16 * 88, I_2 = 44 * 32, I_L = 16, I_G = 32;
    constexpr int NITEMS = I_IN + I_OUT + 2 * I_1 + I_2 + 2 * I_L + I_G;
    for (int it = gw; it < NITEMS; it += NGW) {
        int r = it;
        if (r < I_IN) { p0_transpose_item(a.in[2], 1024, 3840, (bf16*)(ws + WS_WTIN), 1024, 0, 0, scr, r, lane); continue; } r -= I_IN;
        if (r < I_OUT) { p0_transpose_item(a.in[16], 1024, 1024, (bf16*)(ws + WS_WTOUT), 1024, 0, 0, scr, r, lane); continue; } r -= I_OUT;
        if (r < I_1) { p0_transpose_item(a.in[18], 1024, 2816, (bf16*)(ws + WS_WT13), 1024, 0, 1, scr, r, lane); continue; } r -= I_1;
        if (r < I_1) { p0_transpose_item(a.in[19], 1024, 2816, (bf16*)(ws + WS_WT13), 1024, 0, 2, scr, r, lane); continue; } r -= I_1;
        if (r < I_2) { p0_transpose_item(a.in[20], 2816, 1024, (bf16*)(ws + WS_WT2), 2816, 0, 0, scr, r, lane); continue; } r -= I_2;
        if (r < I_L) { p0_transpose_item(a.in[7], 64, 512, (bf16*)(ws + WS_LT), 256, 0, 0, scr, r, lane); continue; } r -= I_L;
        if (r < I_L) { p0_transpose_item(a.in[9], 64, 512, (bf16*)(ws + WS_LT), 256, 64, 0, scr, r, lane); continue; } r -= I_L;
        p0_transpose_item(a.in[10], 128, 512, (bf16*)(ws + WS_LT), 256, 128, 0, scr, r, lane);
    }
    const float* x = a.in[0]; const float* nw = a.in[1]; bf16* XN = (bf16*)((unsigned char*)a.out + DO_XN);
    f32x4 wv[4];
#pragma unroll
    for (int j = 0; j < 4; ++j) wv[j] = *((const f32x4*)nw + 64 * j + lane);
    for (int m = gw; m < M; m += NGW) {
        const f32x4* xr = (const f32x4*)(x + (size_t)m * D) + lane;
        f32x4 v[4]; float s = 0.f;
#pragma unroll
        for (int j = 0; j < 4; ++j) { v[j] = xr[64 * j]; s += (v[j].x * v[j].x + v[j].y * v[j].y) + (v[j].z * v[j].z + v[j].w * v[j].w); }
        const float rstd = __builtin_amdgcn_rsqf(wave_sum(s) * (1.f / D) + 1e-6f);
        u32x2* o8 = (u32x2*)(XN + (size_t)m * D) + lane;
#pragma unroll
        for (int j = 0; j < 4; ++j) { u32x2 o; o.x = pk2(v[j].x * rstd * wv[j].x, v[j].y * rstd * wv[j].y); o.y = pk2(v[j].z * rstd * wv[j].z, v[j].w * rstd * wv[j].w); o8[64 * j] = o; }
    }
    const int gt = blockIdx.x * 512 + tid, NGT = gridDim.x * 512;
    if (gt < 512) { const float* hb = a.in[3]; ((float*)(ws + WS_LB))[gt] = 1.0f / (1.0f + __expf(hb[512 + gt] - hb[gt])); }
    for (int i = gt; i < 2 * M; i += NGT) ((float*)(ws + WS_SSQ1))[i] = 0.f;
}

constexpr int ALD = 264;
__device__ __forceinline__ void phase2(const Args& a, LAS unsigned char* lds) {
    const int tid = threadIdx.x, lane = tid & 63, wave = tid >> 6, tok = lane & 15, q = lane >> 4;
    unsigned char* ws = a.ws;
    const bf16* __restrict__ RW = (const bf16*)(ws + WS_RW); const bf16* __restrict__ LT = (const bf16*)(ws + WS_LT);
    const float* __restrict__ mix = a.in[5]; const float* __restrict__ w0 = a.in[6]; const float* __restrict__ a0 = a.in[8]; const float* __restrict__ k_k = a.in[11]; const float* __restrict__ k_a = a.in[12];
    float* __restrict__ Wd = (float*)(ws + WS_W); bf16* __restrict__ KK = (bf16*)(ws + WS_KK); bf16* __restrict__ BB = (bf16*)(ws + WS_BB); bf16* __restrict__ KM = (bf16*)(ws + WS_KM); bf16* __restrict__ R = (bf16*)(ws + WS_R); bf16* __restrict__ V = (bf16*)(ws + WS_V);
    bf16* __restrict__ G = (bf16*)((unsigned char*)a.out + DO_G);
    LAS bf16* A = (LAS bf16*)lds;
    for (int item = blockIdx.x; item < M / 64; item += gridDim.x) {
        const int row0 = item * 64;
        __syncthreads();
#pragma unroll
        for (int i = 0; i < 4; ++i) {
            const int vi = tid + 512 * i, t = vi >> 5, cg8 = vi & 31, row = row0 + t, col = 1536 + 8 * cg8;
            const u32x4 p = *(const u32x4*)(RW + (size_t)row * 1792 + col);
            u32x4 pp = (u32x4){0u, 0u, 0u, 0u};
            if ((row & (T - 1)) != 0) pp = *(const u32x4*)(RW + (size_t)(row - 1) * 1792 + col);
            const f32x4 m0 = *(const f32x4*)(mix + col), m1 = *(const f32x4*)(mix + col + 4);
            float f[8];
            f[0] = bflo(p.x) + (bflo(pp.x) - bflo(p.x)) * m0.x; f[1] = bfhi(p.x) + (bfhi(pp.x) - bfhi(p.x)) * m0.y;
            f[2] = bflo(p.y) + (bflo(pp.y) - bflo(p.y)) * m0.z; f[3] = bfhi(p.y) + (bfhi(pp.y) - bfhi(p.y)) * m0.w;
            f[4] = bflo(p.z) + (bflo(pp.z) - bflo(p.z)) * m1.x; f[5] = bfhi(p.z) + (bfhi(pp.z) - bfhi(p.z)) * m1.y;
            f[6] = bflo(p.w) + (bflo(pp.w) - bflo(p.w)) * m1.z; f[7] = bfhi(p.w) + (bfhi(pp.w) - bfhi(p.w)) * m1.w;
            if (cg8 < 8) {
#pragma unroll
                for (int j = 0; j < 8; ++j) f[j] = 1.0f - 2.0f * __builtin_amdgcn_rcpf(1.0f + __expf(2.0f * f[j]));
            } else if (cg8 >= 16) {
#pragma unroll
                for (int j = 0; j < 8; ++j) f[j] = sigmf(f[j]);
            }
            u32x4 o; o.x = pk2(f[0], f[1]); o.y = pk2(f[2], f[3]); o.z = pk2(f[4], f[5]); o.w = pk2(f[6], f[7]);
            *(LAS u32x4*)(A + t * ALD + 8 * cg8) = o;
        }
        __syncthreads();
        for (int mt = 0; mt < 4; ++mt) {
            f32x4 aw[4], aa[4], ag[4];
#pragma unroll
            for (int nt = 0; nt < 4; ++nt) { aw[nt] = (f32x4){0.f, 0.f, 0.f, 0.f}; aa[nt] = aw[nt]; ag[nt] = aw[nt]; }
            bf16x8 xf[8];
#pragma unroll
            for (int ks = 0; ks < 8; ++ks) xf[ks] = *(const LAS bf16x8*)(A + (16 * mt + tok) * ALD + 32 * ks + 8 * q);
#pragma unroll
            for (int nt = 0; nt < 4; ++nt) {
                const bf16* lrow = LT + (size_t)(64 * wave + 16 * (tok >> 2) + 4 * nt + (tok & 3)) * 256 + 8 * q;
#pragma unroll
                for (int ks = 0; ks < 8; ++ks) {
                    const bf16x8 wf = *(const bf16x8*)(lrow + 32 * ks);
                    if (ks < 2) aw[nt] = __builtin_amdgcn_mfma_f32_16x16x32_bf16(wf, xf[ks], aw[nt], 0, 0, 0);
                    else if (ks < 4) aa[nt] = __builtin_amdgcn_mfma_f32_16x16x32_bf16(wf, xf[ks], aa[nt], 0, 0, 0);
                    else ag[nt] = __builtin_amdgcn_mfma_f32_16x16x32_bf16(wf, xf[ks], ag[nt], 0, 0, 0);
                }
            }
            const int row = row0 + 16 * mt + tok; const bool hasprev = (row & (T - 1)) != 0;
            const bf16* pr = RW + (size_t)row * 1792; const bf16* ppr = pr - 1792;
            float kkv[4][4], av[4][4]; float ss = 0.f;
#pragma unroll
            for (int nt = 0; nt < 4; ++nt) {
                const int c = 64 * wave + 16 * q + 4 * nt;
                float rr[4], kk[4], vv[4];
#pragma unroll
                for (int part = 0; part < 3; ++part) {
                    const u32x2 p = *(const u32x2*)(pr + 512 * part + c); u32x2 pp = (u32x2){0u, 0u};
                    if (hasprev) pp = *(const u32x2*)(ppr + 512 * part + c);
                    const f32x4 mx = *(const f32x4*)(mix + 512 * part + c);
                    float* dst = part == 0 ? rr : (part == 1 ? kk : vv);
                    dst[0] = bflo(p.x) + (bflo(pp.x) - bflo(p.x)) * mx.x; dst[1] = bfhi(p.x) + (bfhi(pp.x) - bfhi(p.x)) * mx.y;
                    dst[2] = bflo(p.y) + (bflo(pp.y) - bflo(p.y)) * mx.z; dst[3] = bfhi(p.y) + (bfhi(pp.y) - bfhi(p.y)) * mx.w;
                }
                const f32x4 w0v = *(const f32x4*)(w0 + c), a0v = *(const f32x4*)(a0 + c), kkw = *(const f32x4*)(k_k + c), kaw = *(const f32x4*)(k_a + c);
                f32x4 dec; float km[4];
#pragma unroll
                for (int j = 0; j < 4; ++j) {
                    const float z = -(w0v[j] + aw[nt][j]);
                    const float sp = fmaxf(z, 0.f) + __logf(1.0f + __expf(-fabsf(z)));
                    dec[j] = -__expf(-sp - 0.5f);
                    const float al = sigmf(a0v[j] + aa[nt][j]);
                    av[nt][j] = al;
                    kkv[nt][j] = kk[j] * kkw[j]; ss += kkv[nt][j] * kkv[nt][j];
                    km[j] = kk[j] * (1.0f + (al - 1.0f) * kaw[j]);
                }
                const size_t o = (size_t)row * 512 + c;
                *(f32x4*)(Wd + o) = dec;
                u32x2 t2; t2.x = pk2(rr[0], rr[1]); t2.y = pk2(rr[2], rr[3]); *(u32x2*)(R + o) = t2;
                t2.x = pk2(km[0], km[1]); t2.y = pk2(km[2], km[3]); *(u32x2*)(KM + o) = t2;
                t2.x = pk2(vv[0], vv[1]); t2.y = pk2(vv[2], vv[3]); *(u32x2*)(V + o) = t2;
                t2.x = pk2(ag[nt][0], ag[nt][1]); t2.y = pk2(ag[nt][2], ag[nt][3]); *(u32x2*)(G + o) = t2;
            }
            ss += __shfl_xor(ss, 16); ss += __shfl_xor(ss, 32);
            const float inv = 1.0f / fmaxf(sqrtf(ss), 1e-12f);
#pragma unroll
            for (int nt = 0; nt < 4; ++nt) {
                const size_t o = (size_t)row * 512 + 64 * wave + 16 * q + 4 * nt;
                float kn[4];
#pragma unroll
                for (int j = 0; j < 4; ++j) kn[j] = kkv[nt][j] * inv;
                u32x2 t2; t2.x = pk2(kn[0], kn[1]); t2.y = pk2(kn[2], kn[3]); *(u32x2*)(KK + o) = t2;
                t2.x = pk2(-kn[0] * av[nt][0], -kn[1] * av[nt][1]); t2.y = pk2(-kn[2] * av[nt][2], -kn[3] * av[nt][3]); *(u32x2*)(BB + o) = t2;
            }
        }
    }
}
__device__ __forceinline__ void rwkv_scan(const Args& a, LAS unsigned char* lds, int bh, int sl) {
    const int tid = threadIdx.x; unsigned char* ws = a.ws;
    const int b = bh >> 3, h = bh & 7; const size_t m0 = (size_t)b * T; const int c0 = 64 * h;
    const float* Wd = (const float*)(ws + WS_W); const bf16* KK = (const bf16*)(ws + WS_KK); const bf16* BB = (const bf16*)(ws + WS_BB);
    const bf16* KM = (const bf16*)(ws + WS_KM); const bf16* R = (const bf16*)(ws + WS_R); const bf16* V = (const bf16*)(ws + WS_V);
    float* Y = (float*)(ws + WS_Y);
    constexpr int BUF = 5 * 16 * 64 * 4 + 16 * 16 * 4;
    constexpr int NT = T / 16;
    if (tid >= 256) {
        const int lt = tid - 256, st = lt >> 4, l16 = lt & 15, c4 = 4 * l16;
        f32x4 w; u32x2 kk, bb, km, r; bf16 v;
#define RW_LOAD(tile) do { const size_t row = m0 + (size_t)(tile) * 16 + st; const size_t o = row * 512 + c0 + c4; \
        w = *(const f32x4*)(Wd + o); kk = *(const u32x2*)(KK + o); bb = *(const u32x2*)(BB + o); km = *(const u32x2*)(KM + o); r = *(const u32x2*)(R + o); v = V[row * 512 + c0 + 16 * sl + l16]; } while (0)
#define RW_STORE(bufi) do { LAS float* B = (LAS float*)(lds + (bufi) * BUF); const int o = st * 64 + c4; \
        *(LAS f32x4*)(B + o) = w; \
        *(LAS f32x4*)(B + 1024 + o) = (f32x4){bflo(kk.x), bfhi(kk.x), bflo(kk.y), bfhi(kk.y)}; \
        *(LAS f32x4*)(B + 2048 + o) = (f32x4){bflo(bb.x), bfhi(bb.x), bflo(bb.y), bfhi(bb.y)}; \
        *(LAS f32x4*)(B + 3072 + o) = (f32x4){bflo(km.x), bfhi(km.x), bflo(km.y), bfhi(km.y)}; \
        *(LAS f32x4*)(B + 4096 + o) = (f32x4){bflo(r.x), bfhi(r.x), bflo(r.y), bfhi(r.y)}; \
        B[5120 + st * 16 + l16] = bf1(v); } while (0)
        RW_LOAD(0); RW_STORE(0); RW_LOAD(1);
        __syncthreads();
        for (int it = 0; it < NT; ++it) {
            if (it + 1 < NT) RW_STORE((it + 1) & 1);
            if (it + 2 < NT) RW_LOAD(it + 2);
            __syncthreads();
        }
#undef RW_LOAD
#undef RW_STORE
    } else {
        const int wv = tid >> 6, l = tid & 63, rloc = 4 * wv + (l >> 4), kq = l & 15;
        f32x2 S01 = (f32x2){0.f, 0.f}, S23 = S01;
        float* yrow = Y + ((size_t)bh * 64 + 16 * sl + rloc) * T + kq;
        __syncthreads();
        for (int it = 0; it < NT; ++it) {
            const LAS float* B = (const LAS float*)(lds + (it & 1) * BUF);
            float ysel = 0.f;
#pragma unroll 4
            for (int st = 0; st < 16; ++st) {
                const int o = st * 64 + 4 * kq;
                const f32x4 w = *(const LAS f32x4*)(B + o), kk = *(const LAS f32x4*)(B + 1024 + o), bn = *(const LAS f32x4*)(B + 2048 + o), km = *(const LAS f32x4*)(B + 3072 + o), r = *(const LAS f32x4*)(B + 4096 + o);
                const float vv = B[5120 + st * 16 + rloc];
                const f32x2 p2 = S01 * kk.lo + S23 * kk.hi;
                const float sa = rowsum16(p2.x + p2.y);
                const f32x2 sa2 = (f32x2){sa, sa}, vv2 = (f32x2){vv, vv};
                S01 = S01 * w.lo + (sa2 * bn.lo + vv2 * km.lo);
                S23 = S23 * w.hi + (sa2 * bn.hi + vv2 * km.hi);
                const f32x2 y2 = S01 * r.lo + S23 * r.hi;
                const float y = rowsum16(y2.x + y2.y);
                ysel = (kq == st) ? y : ysel;
            }
            yrow[it * 16] = ysel;
            __syncthreads();
        }
    }
}
__device__ __forceinline__ void hgrn_scan(const Args& a, LAS unsigned char* lds, int bh, int sl) {
    const int tid = threadIdx.x; unsigned char* ws = a.ws;
    const int b = bh >> 2, h = bh & 3; const size_t m0 = (size_t)b * T;
    const bf16* HG = (const bf16*)(ws + WS_HG);
    float* OH = (float*)(a.ws + WS_OH);
    constexpr int BUF = 2 * 16 * 128 * 4 + 16 * 16 * 4;
    constexpr int NT = T / 16;
    if (tid >= 256) {
        const int lt = tid - 256, st = lt >> 4, l16 = lt & 15, c8 = 8 * l16;
        u32x4 f, q; bf16 iv;
#define HG_LOAD(tile) do { const bf16* rp = HG + (m0 + (size_t)(tile) * 16 + st) * 2048 + 128 * h; \
        q = *(const u32x4*)(rp + c8); f = *(const u32x4*)(rp + 512 + c8); iv = rp[1024 + 16 * sl + l16]; } while (0)
#define HG_STORE(bufi) do { LAS float* B = (LAS float*)(lds + (bufi) * BUF); const int o = st * 128 + c8; \
        *(LAS f32x4*)(B + o) = (f32x4){bflo(f.x), bfhi(f.x), bflo(f.y), bfhi(f.y)}; *(LAS f32x4*)(B + o + 4) = (f32x4){bflo(f.z), bfhi(f.z), bflo(f.w), bfhi(f.w)}; \
        *(LAS f32x4*)(B + 2048 + o) = (f32x4){bflo(q.x), bfhi(q.x), bflo(q.y), bfhi(q.y)}; *(LAS f32x4*)(B + 2048 + o + 4) = (f32x4){bflo(q.z), bfhi(q.z), bflo(q.w), bfhi(q.w)}; \
        B[4096 + st * 16 + l16] = bf1(iv); } while (0)
        HG_LOAD(0); HG_STORE(0); HG_LOAD(1);
        __syncthreads();
        for (int it = 0; it < NT; ++it) {
            if (it + 1 < NT) HG_STORE((it + 1) & 1);
            if (it + 2 < NT) HG_LOAD(it + 2);
            __syncthreads();
        }
#undef HG_LOAD
#undef HG_STORE
    } else {
        const int wv = tid >> 6, l = tid & 63, rloc = 4 * wv + (l >> 4), kq = l & 15;
        f32x2 S0 = (f32x2){0.f, 0.f}, S1 = S0, S2 = S0, S3 = S0;
        float* orow = OH + ((size_t)bh * 128 + 16 * sl + rloc) * T + kq;
        __syncthreads();
        for (int it = 0; it < NT; ++it) {
            const LAS float* B = (const LAS float*)(lds + (it & 1) * BUF);
            float osel = 0.f;
#pragma unroll 4
            for (int st = 0; st < 16; ++st) {
                const int o = st * 128 + 4 * kq;
                const f32x4 f0 = *(const LAS f32x4*)(B + o), f1 = *(const LAS f32x4*)(B + o + 64), q0 = *(const LAS f32x4*)(B + 2048 + o), q1 = *(const LAS f32x4*)(B + 2048 + o + 64);
                const float iv = B[4096 + st * 16 + rloc];
                const f32x2 iv2 = (f32x2){iv, iv};
                S0 = f0.lo * (S0 - iv2) + iv2; S1 = f0.hi * (S1 - iv2) + iv2; S2 = f1.lo * (S2 - iv2) + iv2; S3 = f1.hi * (S3 - iv2) + iv2;
                const f32x2 p2 = (S0 * q0.lo + S1 * q0.hi) + (S2 * q1.lo + S3 * q1.hi);
                const float p = rowsum16(p2.x + p2.y);
                osel = (kq == st) ? p : osel;
            }
            orow[it * 16] = osel;
            __syncthreads();
        }
    }
}

__device__ __forceinline__ void phase2h(const Args& a) {
    const int tid = threadIdx.x, half = tid >> 8, cp = tid & 255;
    bf16* __restrict__ HG = (bf16*)(a.ws + WS_HG); float* __restrict__ GC = (float*)(a.ws + WS_GC);
    for (int rc = blockIdx.x * 2 + half; rc < M / 32; rc += gridDim.x * 2) {
        bf16* p = HG + (size_t)rc * 32 * 2048 + 2 * cp;
        float g0 = 0.f, g1 = 0.f;
#pragma unroll 8
        for (int t = 0; t < 32; ++t) {
            const unsigned q2 = *(const unsigned*)(p + (size_t)t * 2048), f2 = *(const unsigned*)(p + (size_t)t * 2048 + 512);
            const float f0 = bflo(f2), f1 = bfhi(f2);
            g0 += __logf(f0); g1 += __logf(f1);
            const float e0 = __expf(g0), e1 = __expf(g1);
            *(unsigned*)(p + (size_t)t * 2048) = pk2(bflo(q2) * e0, bfhi(q2) * e1);
            *(unsigned*)(p + (size_t)t * 2048 + 512) = pk2((1.0f - f0) * __builtin_amdgcn_rcpf(e0), (1.0f - f1) * __builtin_amdgcn_rcpf(e1));
        }
        typedef float f32x2_ __attribute__((ext_vector_type(2)));
        *(f32x2_*)(GC + (size_t)rc * 512 + 2 * cp) = (f32x2_){__expf(g0), __expf(g1)};
    }
}

__device__ __forceinline__ bf16x8 ldfrag(const LAS bf16* base, int pitch, int lane) { return *(const LAS bf16x8*)(base + (lane & 15) * pitch + 8 * (lane >> 4)); }
__device__ __forceinline__ void hgrn_seq(const Args& a, LAS unsigned char* lds, int bh, int vh) {
    const int tid = threadIdx.x, lane = tid & 63, w = tid >> 6, q = lane >> 4, r16 = lane & 15;
    const int b = bh >> 2, h = bh & 3; const size_t m0 = (size_t)b * T;
    const bf16* __restrict__ HG = (const bf16*)(a.ws + WS_HG); const float* __restrict__ GC = (const float*)(a.ws + WS_GC);
    float* __restrict__ OH = (float*)(a.ws + WS_OH);
    LAS bf16* Qs = (LAS bf16*)lds; LAS bf16* Ks = Qs + 4352; LAS bf16* KT = Ks + 4352; LAS bf16* VT = KT + 5120; LAS bf16* Am = VT + 2 * 2560; LAS bf16* ST = Am + 1280;
    const int lrow = tid >> 4, c8 = (tid & 15) * 8;
    const bool vmine = (c8 >> 6) == vh; const int vloc = c8 & 63;
    const int swz = 8 * ((lrow >> 3) ^ ((tid & 15) & 3)) + (lrow & 7);
#define HS_SCAT2(dst, v) do { (dst)[0 * 40] = (bf16)((v).x & 0xffffu); (dst)[1 * 40] = (bf16)((v).x >> 16); (dst)[2 * 40] = (bf16)((v).y & 0xffffu); (dst)[3 * 40] = (bf16)((v).y >> 16); \
        (dst)[4 * 40] = (bf16)((v).z & 0xffffu); (dst)[5 * 40] = (bf16)((v).z >> 16); (dst)[6 * 40] = (bf16)((v).w & 0xffffu); (dst)[7 * 40] = (bf16)((v).w >> 16); } while (0)
#define LDSW(base, tile) (*(const LAS bf16x8*)((base) + (16 * (tile) + r16) * 40 + 8 * (q ^ ((2 * (tile) + (r16 >> 3)) & 3))))
    struct HOps { u32x4 gq, gk, gv; f32x4 gam; };
    HOps o0, o1, o2, o3;
#define HS_LOADG(O, n) do { const bf16* rp = HG + (m0 + (size_t)(n) * 32 + lrow) * 2048 + 128 * h + c8; (O).gq = *(const u32x4*)rp; (O).gk = *(const u32x4*)(rp + 512); if (vmine) (O).gv = *(const u32x4*)(rp + 1024); \
        (O).gam = *(const f32x4*)(GC + ((size_t)b * 256 + (n)) * 512 + 128 * h + 16 * w + 4 * q); } while (0)
#define HS_STOREL(O, n) do { *(LAS u32x4*)(Qs + lrow * 136 + c8) = (O).gq; *(LAS u32x4*)(Ks + lrow * 136 + c8) = (O).gk; \
        LAS bf16* kt = KT + c8 * 40 + swz; HS_SCAT2(kt, (O).gk); if (vmine) { LAS bf16* vt = VT + ((n) & 1) * 2560 + vloc * 40 + swz; HS_SCAT2(vt, (O).gv); } } while (0)
    f32x4 S[4];
#pragma unroll
    for (int nt = 0; nt < 4; ++nt) S[nt] = (f32x4){0.f, 0.f, 0.f, 0.f};
    for (int i = tid; i < 8704 / 8; i += 512) *(LAS u32x4*)(ST + 8 * i) = (u32x4){0u, 0u, 0u, 0u};
    o0.gv = (u32x4){0u, 0u, 0u, 0u}; o1.gv = o0.gv; o2.gv = o0.gv; o3.gv = o0.gv;
    HS_LOADG(o0, 0); HS_LOADG(o1, 1); HS_LOADG(o2, 2); HS_LOADG(o3, 3); HS_STOREL(o0, 0);
    BAR_LDS();
    const int omt = w >> 2, ont = w & 3;
#define HS_BODY(C, NX, n) do { \
        const LAS bf16* VTc = VT + ((n) & 1) * 2560; \
        if (w < 4) { \
            const int mt = w >> 1, nt = w & 1; f32x4 acc = (f32x4){0.f, 0.f, 0.f, 0.f}; \
            _Pragma("unroll") for (int ks = 0; ks < 4; ++ks) acc = __builtin_amdgcn_mfma_f32_16x16x32_bf16(ldfrag(Qs + 16 * mt * 136 + 32 * ks, 136, lane), ldfrag(Ks + 16 * nt * 136 + 32 * ks, 136, lane), acc, 0, 0, 0); \
            _Pragma("unroll") for (int i = 0; i < 4; ++i) { const int t = 16 * mt + 4 * q + i, sidx = 16 * nt + r16; Am[t * 40 + sidx] = (bf16)f2bf(sidx <= t ? acc[i] : 0.f); } \
        } \
        f32x4 hk[4]; \
        { const bf16x8 kf = LDSW(KT, w); \
          _Pragma("unroll") for (int nt = 0; nt < 4; ++nt) hk[nt] = __builtin_amdgcn_mfma_f32_16x16x32_bf16(kf, LDSW(VTc, nt), (f32x4){0.f, 0.f, 0.f, 0.f}, 0, 0, 0); } \
        f32x4 oa = (f32x4){0.f, 0.f, 0.f, 0.f}; \
        _Pragma("unroll") for (int ks = 0; ks < 4; ++ks) \
            oa = __builtin_amdgcn_mfma_f32_16x16x32_bf16(ldfrag(Qs + 16 * omt * 136 + 32 * ks, 136, lane), ldfrag(ST + 16 * ont * 136 + 32 * ks, 136, lane), oa, 0, 0, 0); \
        BAR_LDS(); \
        oa = __builtin_amdgcn_mfma_f32_16x16x32_bf16(ldfrag(Am + 16 * omt * 40, 40, lane), LDSW(VTc, ont), oa, 0, 0, 0); \
        *(f32x4*)(OH + (((size_t)bh * 256 + (n)) * 128 + 64 * vh + 16 * ont + r16) * 32 + 16 * omt + 4 * q) = oa; \
        _Pragma("unroll") for (int nt = 0; nt < 4; ++nt) { \
            S[nt] = (C).gam * (S[nt] + hk[nt]); \
            u32x2 t2; t2.x = pk2(S[nt][0], S[nt][1]); t2.y = pk2(S[nt][2], S[nt][3]); \
            *(LAS u32x2*)(ST + (16 * nt + r16) * 136 + 16 * w + 4 * q) = t2; } \
        HS_STOREL(NX, (n) + 1); \
        HS_LOADG(C, ((n) + 4 < T / 32 ? (n) + 4 : T / 32 - 1)); \
        BAR_LDS(); } while (0)
    for (int n = 0; n < T / 32; n += 4) { HS_BODY(o0, o1, n); HS_BODY(o1, o2, n + 1); HS_BODY(o2, o3, n + 2); HS_BODY(o3, o0, n + 3); }
#undef HS_BODY
#undef HS_SCAT2
#undef LDSW
#undef HS_LOADG
#undef HS_STOREL
}

__device__ __forceinline__ void phase2c(const Args& a, LAS unsigned char* lds) {
    const int tid = threadIdx.x, lane = tid & 63, w = tid >> 6, q = lane >> 4, r16 = lane & 15;
    unsigned char* ws = a.ws;
    const float* __restrict__ LW = (const float*)(ws + WS_W); const bf16* __restrict__ KK = (const bf16*)(ws + WS_KK); const bf16* __restrict__ BB = (const bf16*)(ws + WS_BB);
    const bf16* __restrict__ KM = (const bf16*)(ws + WS_KM); const bf16* __restrict__ R = (const bf16*)(ws + WS_R); const bf16* __restrict__ V = (const bf16*)(ws + WS_V);
    unsigned char* __restrict__ CA = ws + WS_CA; unsigned char* __restrict__ CB = (unsigned char*)a.out + DO_CB; float* __restrict__ CG = (float*)(ws + WS_CG);
    LAS float* Gs = (LAS float*)lds; LAS float* Lm = Gs + 2048; LAS float* Sg = Lm + 32 * 36;
    LAS bf16* At = (LAS bf16*)(Sg + 256); LAS bf16* Rt = At + 2304; LAS bf16* Bt_ = Rt + 2304; LAS bf16* Kt_ = Bt_ + 2304;
    LAS bf16* AT = Kt_ + 2304; LAS bf16* VT = AT + 2560; LAS bf16* KhT = VT + 2560; LAS bf16* BhT = KhT + 2560; LAS bf16* AKT = BhT + 2560; LAS bf16* TI = AKT + 1280;
    const int t = tid >> 4, c4 = 4 * (tid & 15);
    const int tsw = 8 * ((t >> 3) ^ ((c4 >> 3) & 3)) + (t & 7);
#define LDSW(base, tile) (*(const LAS bf16x8*)((base) + (16 * (tile) + r16) * 40 + 8 * (q ^ ((2 * (tile) + (r16 >> 3)) & 3))))
    f32x4 lw4; u32x2 kk2, bb2, km2, r2, v2;
#define P2C_LOAD(itx) do { const int bh_ = (itx) & 31, n_ = (itx) >> 5; const size_t o_ = ((size_t)(bh_ >> 3) * T + 32 * n_ + t) * 512 + 64 * (bh_ & 7) + c4; \
        lw4 = *(const f32x4*)(LW + o_); kk2 = *(const u32x2*)(KK + o_); bb2 = *(const u32x2*)(BB + o_); km2 = *(const u32x2*)(KM + o_); r2 = *(const u32x2*)(R + o_); v2 = *(const u32x2*)(V + o_); } while (0)
    if ((int)blockIdx.x < 8192) P2C_LOAD(blockIdx.x);
    for (int it = blockIdx.x; it < 8192; it += gridDim.x) {
        unsigned char* ca = CA + (size_t)it * CA_SZ; unsigned char* cb = CB + (size_t)it * CB_SZ;
        *(LAS f32x4*)(Gs + t * 64 + c4) = lw4;
        BAR_LDS();
        if (tid < 256) { const int c = tid & 63, sg = tid >> 6; float g = 0.f;
#pragma unroll
            for (int tt = 0; tt < 8; ++tt) { g += Gs[(8 * sg + tt) * 64 + c]; Gs[(8 * sg + tt) * 64 + c] = g; }
            Sg[sg * 64 + c] = g; }
        BAR_LDS();
        {
            f32x4 off = (f32x4){0.f, 0.f, 0.f, 0.f}, offp = off, tot = off;
#pragma unroll
            for (int sg = 0; sg < 4; ++sg) { const f32x4 sv = *(const LAS f32x4*)(Sg + sg * 64 + c4); if (sg < (t >> 3)) off += sv; if (t > 0 && sg < ((t - 1) >> 3)) offp += sv; tot += sv; }
            const f32x4 g4 = *(const LAS f32x4*)(Gs + t * 64 + c4) + off, gl4 = tot;
            f32x4 gp4 = (f32x4){0.f, 0.f, 0.f, 0.f}; if (t > 0) gp4 = *(const LAS f32x4*)(Gs + (t - 1) * 64 + c4) + offp;
            const float kkf[4] = {bflo(kk2.x), bfhi(kk2.x), bflo(kk2.y), bfhi(kk2.y)}, bbf[4] = {bflo(bb2.x), bfhi(bb2.x), bflo(bb2.y), bfhi(bb2.y)};
            const float kmf[4] = {bflo(km2.x), bfhi(km2.x), bflo(km2.y), bfhi(km2.y)}, rf[4] = {bflo(r2.x), bfhi(r2.x), bflo(r2.y), bfhi(r2.y)};
            float va[4], vr[4], vb[4], vk[4], vbh[4], vkh[4];
#pragma unroll
            for (int j = 0; j < 4; ++j) {
                const float ea = __expf(gp4[j]), eg = __expf(g4[j]), en = __expf(-g4[j]), el = __expf(gl4[j] - g4[j]);
                va[j] = -kkf[j] * ea; vr[j] = rf[j] * eg; vb[j] = -bbf[j] * en; vk[j] = kmf[j] * en; vbh[j] = -bbf[j] * el; vkh[j] = kmf[j] * el;
            }
            u32x2 p; p.x = pk2(va[0], va[1]); p.y = pk2(va[2], va[3]); *(LAS u32x2*)(At + t * 72 + c4) = p;
            p.x = pk2(vr[0], vr[1]); p.y = pk2(vr[2], vr[3]); *(LAS u32x2*)(Rt + t * 72 + c4) = p; *(u32x2*)(ca + 4096 + (t * 64 + c4) * 2) = p;
            p.x = pk2(vb[0], vb[1]); p.y = pk2(vb[2], vb[3]); *(LAS u32x2*)(Bt_ + t * 72 + c4) = p;
            p.x = pk2(vk[0], vk[1]); p.y = pk2(vk[2], vk[3]); *(LAS u32x2*)(Kt_ + t * 72 + c4) = p;
            const unsigned vraw[4] = {v2.x & 0xffffu, v2.x >> 16, v2.y & 0xffffu, v2.y >> 16};
#pragma unroll
            for (int j = 0; j < 4; ++j) {
                const int d = (c4 + j) * 40 + tsw;
                AT[d] = (bf16)f2bf(va[j]); VT[d] = (bf16)vraw[j]; KhT[d] = (bf16)f2bf(vkh[j]); BhT[d] = (bf16)f2bf(vbh[j]);
            }
            if (t == 31) *(f32x4*)(CG + (size_t)it * 64 + c4) = (f32x4){__expf(gl4[0]), __expf(gl4[1]), __expf(gl4[2]), __expf(gl4[3])};
        }
        { const int itn = it + (int)gridDim.x; P2C_LOAD(itn < 8192 ? itn : it); }
        BAR_LDS();
        {
            const int p = w >> 1, mt = w & 1;
            const LAS bf16* Ab = (p < 2) ? At : Rt; const LAS bf16* Bb = (p & 1) ? Kt_ : Bt_;
            const bf16x8 a0 = ldfrag(Ab + 16 * mt * 72, 72, lane), a1 = ldfrag(Ab + 16 * mt * 72 + 32, 72, lane);
#pragma unroll
            for (int nt = 0; nt < 2; ++nt) {
                f32x4 acc = __builtin_amdgcn_mfma_f32_16x16x32_bf16(a0, ldfrag(Bb + 16 * nt * 72, 72, lane), (f32x4){0.f, 0.f, 0.f, 0.f}, 0, 0, 0);
                acc = __builtin_amdgcn_mfma_f32_16x16x32_bf16(a1, ldfrag(Bb + 16 * nt * 72 + 32, 72, lane), acc, 0, 0, 0);
                const int sidx = 16 * nt + r16, tb = 16 * mt + 4 * q;
                float m[4];
#pragma unroll
                for (int i = 0; i < 4; ++i) m[i] = (p < 2 ? (sidx < tb + i) : (sidx <= tb + i)) ? acc[i] : 0.f;
                if (p == 0) {
#pragma unroll
                    for (int i = 0; i < 4; ++i) Lm[(tb + i) * 36 + sidx] = m[i];
                } else if (p == 1) { u32x2 pp; pp.x = pk2(m[0], m[1]); pp.y = pk2(m[2], m[3]); *(LAS u32x2*)(AKT + sidx * 40 + tb) = pp; }
                else { bf16* dst = (bf16*)(p == 2 ? ca + 12288 : cb + 8192);
#pragma unroll
                    for (int i = 0; i < 4; ++i) dst[(tb + i) * 32 + sidx] = (bf16)f2bf(m[i]); }
            }
        }
        BAR_LDS();
        if (w == 0) {
            const int c = lane & 31; float Tc[32];
#pragma unroll
            for (int tt = 0; tt < 32; ++tt) { float ac[4] = {(tt == c) ? 1.f : 0.f, 0.f, 0.f, 0.f};
#pragma unroll
                for (int s2 = 0; s2 < tt; ++s2) ac[s2 & 3] = fmaf(Lm[tt * 36 + s2], Tc[s2], ac[s2 & 3]);
                Tc[tt] = (ac[0] + ac[1]) + (ac[2] + ac[3]); }
            if (lane < 32) {
#pragma unroll
                for (int tt = 0; tt < 32; ++tt) TI[tt * 40 + c] = (bf16)f2bf(Tc[tt]); }
        } else {
            for (int pc = tid - 64; pc < 768; pc += 448) {
                const int tile = pc >> 8, row = (pc >> 2) & 63, part = pc & 3;
                const LAS bf16* src = (tile == 0 ? KhT : (tile == 1 ? VT : BhT)) + row * 40 + 8 * (part ^ ((row >> 3) & 3));
                unsigned char* dst = (tile == 0 ? cb : (tile == 1 ? cb + 4096 : ca + 8192)) + row * 64 + part * 16;
                *(u32x4*)dst = *(const LAS u32x4*)src;
            }
        }
        BAR_LDS();
        if (w < 4) {
            const bf16x8 af = LDSW(AT, w);
#pragma unroll
            for (int nt = 0; nt < 2; ++nt) {
                const f32x4 acc = __builtin_amdgcn_mfma_f32_16x16x32_bf16(af, ldfrag(TI + 16 * nt * 40, 40, lane), (f32x4){0.f, 0.f, 0.f, 0.f}, 0, 0, 0);
                u32x2 pp; pp.x = pk2(acc[0], acc[1]); pp.y = pk2(acc[2], acc[3]);
                *(u32x2*)(ca + ((16 * nt + r16) * 64 + 16 * w + 4 * q) * 2) = pp;
            }
            const int ms = w >> 1, nt = w & 1;
            const f32x4 acc = __builtin_amdgcn_mfma_f32_16x16x32_bf16(ldfrag(AKT + 16 * ms * 40, 40, lane), ldfrag(TI + 16 * nt * 40, 40, lane), (f32x4){0.f, 0.f, 0.f, 0.f}, 0, 0, 0);
            u32x2 pp; pp.x = pk2(acc[0], acc[1]); pp.y = pk2(acc[2], acc[3]);
            *(u32x2*)(cb + 10240 + ((16 * nt + r16) * 32 + 16 * ms + 4 * q) * 2) = pp;
        }
    }
#undef LDSW
#undef P2C_LOAD
}

__device__ __forceinline__ void rwkv_seq(const Args& a, LAS unsigned char* lds, int bh, int vh) {
    const int tid = threadIdx.x, lane = tid & 63, w = tid >> 6, q = lane >> 4, r16 = lane & 15;
    unsigned char* ws = a.ws;
    const unsigned char* __restrict__ CA = ws + WS_CA; const unsigned char* __restrict__ CB = (const unsigned char*)a.out + DO_CB; const float* __restrict__ CG = (const float*)(ws + WS_CG);
    float* __restrict__ Y = (float*)(ws + WS_Y);
    LAS bf16* HT = (LAS bf16*)lds; LAS bf16* UT = HT + 2304; LAS bf16* SL = UT + 1280;
    const int mk = w >> 1, ntl = w & 1, mt1 = (w >> 1) & 1, vt = 2 * vh + ntl;
    int gofs[4], ldst[4]; bool inB[4], val[4];
#pragma unroll
    for (int r = 0; r < 4; ++r) {
        const int idx = tid + 512 * r; val[r] = idx < 1664; inB[r] = idx >= 896;
        int ld;
        if (idx < 896) { const int i2 = idx; gofs[r] = i2 * 16;
            if (i2 < 256) ld = (i2 >> 3) * 72 + (i2 & 7) * 8;
            else if (i2 < 512) ld = 2304 + ((i2 - 256) >> 3) * 72 + ((i2 - 256) & 7) * 8;
            else if (i2 < 768) ld = 4608 + ((i2 - 512) >> 2) * 40 + ((i2 - 512) & 3) * 8;
            else ld = 7168 + ((i2 - 768) >> 2) * 40 + ((i2 - 768) & 3) * 8;
        } else { const int j2 = idx - 896; gofs[r] = j2 * 16;
            if (j2 < 256) ld = 8448 + (j2 >> 2) * 40 + (j2 & 3) * 8;
            else if (j2 < 512) ld = 11008 + ((j2 - 256) >> 2) * 40 + ((j2 - 256) & 3) * 8;
            else if (j2 < 640) ld = 13568 + ((j2 - 512) >> 2) * 40 + ((j2 - 512) & 3) * 8;
            else ld = 14848 + ((j2 - 640) >> 2) * 40 + ((j2 - 640) & 3) * 8;
        }
        ldst[r] = ld;
    }
    u32x4 st[4]; f32x4 gcur, gnx;
#define RS_LOAD(n) do { const size_t it_ = (size_t)(n) * 32 + bh; const unsigned char* ca = CA + it_ * CA_SZ; const unsigned char* cb = CB + it_ * CB_SZ; \
        _Pragma("unroll") for (int r = 0; r < 4; ++r) if (val[r]) st[r] = *(const u32x4*)((inB[r] ? cb : ca) + gofs[r]); \
        gnx = *(const f32x4*)(CG + it_ * 64 + 16 * mk + 4 * q); } while (0)
#define RS_PUT(n) do { LAS bf16* sl = SL + ((n) & 1) * 16128; _Pragma("unroll") for (int r = 0; r < 4; ++r) if (val[r]) *(LAS u32x4*)(sl + ldst[r]) = st[r]; } while (0)
    f32x4 H0 = (f32x4){0.f, 0.f, 0.f, 0.f};
    for (int i = tid; i < 2304 / 8; i += 512) *(LAS u32x4*)(HT + 8 * i) = (u32x4){0u, 0u, 0u, 0u};
    RS_LOAD(0); RS_PUT(0); gcur = gnx;
    BAR_LDS();
    for (int n = 0; n < T / 32; ++n) {
        RS_LOAD((n + 1 < T / 32 ? n + 1 : T / 32 - 1));
        const LAS bf16* sl = SL + (n & 1) * 16128;
        const bf16x8 vth = ldfrag(sl + 11008 + 16 * vt * 40, 40, lane);
        f32x4 y = (f32x4){0.f, 0.f, 0.f, 0.f};
        if (w < 4) {
            const bf16x8 h0 = ldfrag(HT + 16 * ntl * 72, 72, lane), h1 = ldfrag(HT + 16 * ntl * 72 + 32, 72, lane);
            f32x4 u = __builtin_amdgcn_mfma_f32_16x16x32_bf16(ldfrag(sl + 14848 + 16 * mt1 * 40, 40, lane), vth, (f32x4){0.f, 0.f, 0.f, 0.f}, 0, 0, 0);
            u = __builtin_amdgcn_mfma_f32_16x16x32_bf16(ldfrag(sl + 16 * mt1 * 72, 72, lane), h0, u, 0, 0, 0);
            u = __builtin_amdgcn_mfma_f32_16x16x32_bf16(ldfrag(sl + 16 * mt1 * 72 + 32, 72, lane), h1, u, 0, 0, 0);
            y = __builtin_amdgcn_mfma_f32_16x16x32_bf16(ldfrag(sl + 13568 + 16 * mt1 * 40, 40, lane), vth, y, 0, 0, 0);
            y = __builtin_amdgcn_mfma_f32_16x16x32_bf16(ldfrag(sl + 2304 + 16 * mt1 * 72, 72, lane), h0, y, 0, 0, 0);
            y = __builtin_amdgcn_mfma_f32_16x16x32_bf16(ldfrag(sl + 2304 + 16 * mt1 * 72 + 32, 72, lane), h1, y, 0, 0, 0);
            u32x2 pp; pp.x = pk2(u[0], u[1]); pp.y = pk2(u[2], u[3]); *(LAS u32x2*)(UT + (16 * ntl + r16) * 40 + 16 * mt1 + 4 * q) = pp;
        }
        const f32x4 hn0 = __builtin_amdgcn_mfma_f32_16x16x32_bf16(ldfrag(sl + 8448 + 16 * mk * 40, 40, lane), vth, gcur * H0, 0, 0, 0);
        BAR_LDS();
        const bf16x8 uf = ldfrag(UT + 16 * ntl * 40, 40, lane);
        if (w < 4) {
            y = __builtin_amdgcn_mfma_f32_16x16x32_bf16(ldfrag(sl + 7168 + 16 * mt1 * 40, 40, lane), uf, y, 0, 0, 0);
            *(f32x4*)(Y + (((size_t)bh * 256 + n) * 64 + 16 * vt + r16) * 32 + 16 * mt1 + 4 * q) = y;
        }
        H0 = __builtin_amdgcn_mfma_f32_16x16x32_bf16(ldfrag(sl + 4608 + 16 * mk * 40, 40, lane), uf, hn0, 0, 0, 0);
        { u32x2 pp; pp.x = pk2(H0[0], H0[1]); pp.y = pk2(H0[2], H0[3]); *(LAS u32x2*)(HT + (16 * ntl + r16) * 72 + 16 * mk + 4 * q) = pp; }
        RS_PUT(n + 1); gcur = gnx;
        BAR_LDS();
    }
#undef RS_LOAD
#undef RS_PUT
}
__device__ __forceinline__ void phase3(const Args& a, LAS unsigned char* lds) {
    for (int item = blockIdx.x; item < 96; item += gridDim.x) {
        __syncthreads();
        if (item < 64) rwkv_seq(a, lds, item >> 1, item & 1); else hgrn_seq(a, lds, (item - 64) >> 1, (item - 64) & 1);
    }
}

__device__ __forceinline__ float red8(float v) { v = dpp_add<0xB1>(v); v = dpp_add<0x4E>(v); v = dpp_add<0x141>(v); return v; }
__device__ __forceinline__ void phase4(const Args& a, LAS unsigned char* lds) {
    const int tid = threadIdx.x, lane = tid & 63, wave = tid >> 6, gw = blockIdx.x * 8 + wave, NGW = gridDim.x * 8, tk = lane >> 3, cg = lane & 7;
    unsigned char* ws = a.ws;
    bf16* __restrict__ MIX = (bf16*)(ws + WS_MIX);
    const float* __restrict__ Y = (const float*)(ws + WS_Y); const float* __restrict__ OH = (const float*)(a.ws + WS_OH);
    const bf16* __restrict__ R = (const bf16*)(ws + WS_R); const bf16* __restrict__ KM = (const bf16*)(ws + WS_KM); const bf16* __restrict__ V = (const bf16*)(ws + WS_V); const bf16* __restrict__ G = (const bf16*)((unsigned char*)a.out + DO_G);
    const bf16* __restrict__ HG = (const bf16*)(ws + WS_HG);
    const float* __restrict__ r_k = a.in[13]; const float* __restrict__ ln_w = a.in[14]; const float* __restrict__ ln_b = a.in[15]; const float* __restrict__ hnw = a.in[4];
    LAS float* Yt = (LAS float*)(lds + wave * 17408);
    constexpr int N_RW = 32 * 128, N_HG = 16 * 128;
    for (int it = gw; it < N_RW + N_HG; it += NGW) {
        if (it < N_RW) {
            const int bh = it >> 7, tile = it & 127, b = bh >> 3, h = bh & 7, t0 = tile * 64;
            const float* yp = Y + ((size_t)bh * 256 + 2 * tile + (lane >> 5)) * 64 * 32 + (lane & 31);
#pragma unroll 16
            for (int v = 0; v < 64; ++v) Yt[v * 65 + lane] = yp[v * 32];
            asm volatile("s_waitcnt lgkmcnt(0)" ::: "memory");
            const int c = 64 * h + 8 * cg;
            const f32x4 k0 = *(const f32x4*)(r_k + c), k1 = *(const f32x4*)(r_k + c + 4), w0 = *(const f32x4*)(ln_w + c), w1 = *(const f32x4*)(ln_w + c + 4), b0 = *(const f32x4*)(ln_b + c), b1 = *(const f32x4*)(ln_b + c + 4);
            const float kr[8] = {k0.x, k0.y, k0.z, k0.w, k1.x, k1.y, k1.z, k1.w}, lw[8] = {w0.x, w0.y, w0.z, w0.w, w1.x, w1.y, w1.z, w1.w}, lb[8] = {b0.x, b0.y, b0.z, b0.w, b1.x, b1.y, b1.z, b1.w};
#pragma unroll 2
            for (int i = 0; i < 8; ++i) {
                const int tok = 8 * i + tk; const size_t row = (size_t)b * T + t0 + tok, o = row * 512 + c;
                const u32x4 rr = *(const u32x4*)(R + o), kk = *(const u32x4*)(KM + o), vv = *(const u32x4*)(V + o), gg = *(const u32x4*)(G + o);
                float y[8]; float s = 0.f;
#pragma unroll
                for (int j = 0; j < 8; ++j) { y[j] = Yt[(8 * cg + j) * 65 + tok]; s += y[j]; }
                const float mu = red8(s) * (1.f / 64.f); float q = 0.f;
#pragma unroll
                for (int j = 0; j < 8; ++j) { y[j] -= mu; q += y[j] * y[j]; }
                const float rs = __builtin_amdgcn_rsqf(red8(q) * (1.f / 64.f) + 64e-5f);
                const float rv[8] = {bflo(rr.x), bfhi(rr.x), bflo(rr.y), bfhi(rr.y), bflo(rr.z), bfhi(rr.z), bflo(rr.w), bfhi(rr.w)};
                const float kv[8] = {bflo(kk.x), bfhi(kk.x), bflo(kk.y), bfhi(kk.y), bflo(kk.z), bfhi(kk.z), bflo(kk.w), bfhi(kk.w)};
                const float vf[8] = {bflo(vv.x), bfhi(vv.x), bflo(vv.y), bfhi(vv.y), bflo(vv.z), bfhi(vv.z), bflo(vv.w), bfhi(vv.w)};
                const float gf[8] = {bflo(gg.x), bfhi(gg.x), bflo(gg.y), bfhi(gg.y), bflo(gg.z), bfhi(gg.z), bflo(gg.w), bfhi(gg.w)};
                float dot = 0.f;
#pragma unroll
                for (int j = 0; j < 8; ++j) dot += rv[j] * kv[j] * kr[j];
                dot = red8(dot);
                float e[8];
#pragma unroll
                for (int j = 0; j < 8; ++j) e[j] = (y[j] * rs * lw[j] + lb[j] + dot * vf[j]) * gf[j];
                u32x4 ov; ov.x = pk2(e[0], e[1]); ov.y = pk2(e[2], e[3]); ov.z = pk2(e[4], e[5]); ov.w = pk2(e[6], e[7]);
                *(u32x4*)(MIX + row * 1024 + 512 + c) = ov;
            }
            asm volatile("s_waitcnt lgkmcnt(0)" ::: "memory");
        } else {
            const int i2 = it - N_RW, bh = i2 >> 7, tile = i2 & 127, b = bh >> 2, h = bh & 3, t0 = tile * 64;
            const float* op = OH + ((size_t)bh * 256 + 2 * tile + (lane >> 5)) * 128 * 32 + (lane & 31);
            float ss = 0.f;
#pragma unroll 16
            for (int v = 0; v < 128; ++v) { const float o = op[v * 32]; ss += o * o; }
            Yt[64 * 65 + lane] = __builtin_amdgcn_rsqf(ss * (1.f / 128.f) + 1e-6f);
            for (int half = 0; half < 2; ++half) {
#pragma unroll 16
                for (int v = 0; v < 64; ++v) Yt[v * 65 + lane] = op[(64 * half + v) * 32];
                asm volatile("s_waitcnt lgkmcnt(0)" ::: "memory");
                const int c = 128 * h + 64 * half + 8 * cg;
                const f32x4 w0 = *(const f32x4*)(hnw + c), w1 = *(const f32x4*)(hnw + c + 4);
                const float wv[8] = {w0.x, w0.y, w0.z, w0.w, w1.x, w1.y, w1.z, w1.w};
#pragma unroll 2
                for (int i = 0; i < 8; ++i) {
                    const int tok = 8 * i + tk; const size_t row = (size_t)b * T + t0 + tok;
                    const u32x4 gg = *(const u32x4*)(HG + row * 2048 + 1536 + c);
                    const float rs = Yt[64 * 65 + tok];
                    const float gf[8] = {bflo(gg.x), bfhi(gg.x), bflo(gg.y), bfhi(gg.y), bflo(gg.z), bfhi(gg.z), bflo(gg.w), bfhi(gg.w)};
                    float e[8];
#pragma unroll
                    for (int j = 0; j < 8; ++j) e[j] = Yt[(8 * cg + j) * 65 + tok] * rs * wv[j] * gf[j] * sigmf(gf[j]);
                    u32x4 ov; ov.x = pk2(e[0], e[1]); ov.y = pk2(e[2], e[3]); ov.z = pk2(e[4], e[5]); ov.w = pk2(e[6], e[7]);
                    *(u32x4*)(MIX + row * 1024 + c) = ov;
                }
                asm volatile("s_waitcnt lgkmcnt(0)" ::: "memory");
            }
        }
    }
}

__device__ __forceinline__ void phase8(const Args& a) {
    const int tid = threadIdx.x, lane = tid & 63, wave = tid >> 6, gw = blockIdx.x * 8 + wave, NGW = gridDim.x * 8;
    const float* fw = a.in[21]; const float* ssq = (const float*)(a.ws + WS_SSQ2);
    f32x4 wv[4];
#pragma unroll
    for (int j = 0; j < 4; ++j) wv[j] = *((const f32x4*)fw + 64 * j + lane);
    for (int m = gw; m < M; m += NGW) {
        const float rstd = __builtin_amdgcn_rsqf(ssq[m] * (1.f / D) + 1e-6f);
        f32x4* xr = (f32x4*)(a.out + (size_t)m * D) + lane;
#pragma unroll
        for (int j = 0; j < 4; ++j) { f32x4 v = xr[64 * j]; v = v * rstd * wv[j]; xr[64 * j] = v; }
    }
}

__global__ void __launch_bounds__(512, 2) fwd_kernel(Args a) {
    extern __shared__ __attribute__((aligned(16))) unsigned char lds_raw[];
    LAS unsigned char* lds = (LAS unsigned char*)lds_raw;
    cg::grid_group grid = cg::this_grid();
    unsigned char* ws = a.ws;
    volatile LAS unsigned* bst = (volatile LAS unsigned*)(lds + LDS_BYTES - 16);
    if (threadIdx.x < 4) bst[threadIdx.x] = 0u;
    __syncthreads();
    XcdBarrier xbar = xcd_barrier_post((unsigned*)(ws + WS_BAR), bst);
    const int lo = a.ph_lo, hi = a.ph_hi;
#define IN(k) (lo <= (k) && (k) < hi)
#define SEAM(k) do { if ((k) + 1 < hi) { if ((k) == 0) grid.sync(); else xcd_barrier(xbar); } } while (0)
    {
        if (IN(0)) { phase0(a, lds); SEAM(0); }
        if (IN(1)) {
            pg8::Gemm g{(const pg8::bf16_t*)((unsigned char*)a.out + DO_XN), (const pg8::bf16_t*)(ws + WS_WTIN), M, 3840, 1024}; pg8::StaticOrder S; S.init(M, 3840, gridDim.x, blockIdx.x);
            pg8::EpiProj E{(pg8::bf16_t*)(ws + WS_HG), (pg8::bf16_t*)(ws + WS_RW), (const float*)(ws + WS_LB)};
            pg8::gemm_phase<pg8::EpiProj, pg8::StaticOrder>((PG8_LAS unsigned char*)lds, g, S, E, nullptr); SEAM(1);
        }
        if (IN(2)) { phase2(a, lds); phase2h(a); SEAM(2); }
        if (IN(3)) { phase2c(a, lds); SEAM(3); }
        if (IN(4)) { phase3(a, lds); SEAM(4); }
        if (IN(5)) { phase4(a, lds); SEAM(5); }
        if (IN(6)) {
            pg8::Gemm g{(const pg8::bf16_t*)(ws + WS_MIX), (const pg8::bf16_t*)(ws + WS_WTOUT), M, 1024, 1024}; pg8::StaticOrder S; S.init(M, 1024, gridDim.x, blockIdx.x);
            pg8::EpiRes<true> E{a.in[0], a.out, (pg8::bf16_t*)(ws + WS_X1B), a.in[17], (float*)(ws + WS_SSQ1)};
            pg8::gemm_phase<pg8::EpiRes<true>, pg8::StaticOrder>((PG8_LAS unsigned char*)lds, g, S, E, nullptr); SEAM(6);
        }
        if (IN(7)) {
            pg8::Gemm g{(const pg8::bf16_t*)(ws + WS_X1B), (const pg8::bf16_t*)(ws + WS_WT13), M, 2 * FF, 1024}; pg8::StaticOrder S; S.init(M, 2 * FF, gridDim.x, blockIdx.x);
            pg8::EpiGlu E{(pg8::bf16_t*)(ws + WS_U), (const float*)(ws + WS_SSQ1)};
            pg8::gemm_phase<pg8::EpiGlu, pg8::StaticOrder>((PG8_LAS unsigned char*)lds, g, S, E, nullptr); SEAM(7);
        }
        if (IN(8)) {
            pg8::Gemm g{(const pg8::bf16_t*)(ws + WS_U), (const pg8::bf16_t*)(ws + WS_WT2), M, 1024, FF}; pg8::StaticOrder S; S.init(M, 1024, gridDim.x, blockIdx.x);
            pg8::EpiRes<false> E{a.out, a.out, nullptr, nullptr, (float*)(ws + WS_SSQ2)};
            pg8::gemm_phase<pg8::EpiRes<false>, pg8::StaticOrder>((PG8_LAS unsigned char*)lds, g, S, E, nullptr); SEAM(8);
        }
        if (IN(9)) phase8(a);
    }
#undef IN
#undef SEAM
}

extern "C" void kernel_launch(void* const* d_in, const int* in_sizes, int n_in, void* d_out, int out_size, void* d_ws, size_t ws_size, hipStream_t stream) {
    static int grid = 0;
    if (grid == 0) {
        if (n_in != 22 || out_size != M * D || ws_size < WS_END) { fprintf(stderr, "kernel_launch: unexpected problem (n_in %d, out %d, ws %zu)\n", n_in, out_size, ws_size); grid = -1; return; }
        int dev = 0, cus = 0, per_cu = 0;
        if (hipGetDevice(&dev) != hipSuccess || hipDeviceGetAttribute(&cus, hipDeviceAttributeMultiprocessorCount, dev) != hipSuccess) { grid = -1; return; }
        if (hipFuncSetAttribute((const void*)fwd_kernel, hipFuncAttributeMaxDynamicSharedMemorySize, LDS_BYTES) != hipSuccess) { fprintf(stderr, "kernel_launch: hipFuncSetAttribute failed\n"); grid = -1; return; }
        if (hipOccupancyMaxActiveBlocksPerMultiprocessor(&per_cu, (const void*)fwd_kernel, 512, LDS_BYTES) != hipSuccess || per_cu < 1) { fprintf(stderr, "kernel_launch: occupancy query says %d\n", per_cu); per_cu = 1; }
        (void)hipGetLastError();
        grid = cus * 1;
    }
    if (grid < 0) return;
    if (hipMemsetAsync((char*)d_ws + WS_BAR, 0, 16384, stream) != hipSuccess) { fprintf(stderr, "kernel_launch: memset failed\n"); return; }
    Args a{};
    for (int i = 0; i < 22; ++i) a.in[i] = (const float*)d_in[i];
    a.out = (float*)d_out; a.ws = (unsigned char*)d_ws;
    if (N_LAUNCHES == 1) {
        a.ph_lo = 0; a.ph_hi = NPHASE;
        void* args[] = {&a};
        hipError_t e = hipLaunchCooperativeKernel((const void*)fwd_kernel, dim3(grid), dim3(512), args, LDS_BYTES, stream);
        if (e != hipSuccess) fprintf(stderr, "cooperative launch failed: %s (grid %d)\n", hipGetErrorString(e), grid);
    } else {
        for (int ph = 0; ph < NPHASE; ++ph) { a.ph_lo = ph; a.ph_hi = ph + 1; hipLaunchKernelGGL(fwd_kernel, dim3(grid), dim3(512), LDS_BYTES, stream, a);
#ifdef PROBE_DUP
            if (ph == PROBE_DUP) hipLaunchKernelGGL(fwd_kernel, dim3(grid), dim3(512), LDS_BYTES, stream, a);
#endif
        }
    }
}
```
